# Optimizing an MI355X kernel written in HIP

```python
import math
import jax, jax.numpy as jnp
from jax import lax
import numpy as np

D_MODEL = 1024
BATCH = 16
SEQ = 2048
DEPTH = 1

CHUNK = 64
EPS = 1e-6
S5_WIDTH = 512
S5_GROUP = 16
S5_GROUPS = S5_WIDTH // S5_GROUP
S5_STATE = 64
HG_WIDTH = 512
HG_HEAD_DIM = 128
HG_HEADS = HG_WIDTH // HG_HEAD_DIM
D_FF = 2816
CONV_W = 3
N_IN = S5_WIDTH + 4 * HG_WIDTH + 2 * D_MODEL

kernel_name = "hybrid_s5_hgrn2_convffn_block"


def rmsnorm(x, gain):
    x32 = x.astype(jnp.float32)
    y = x32 * lax.rsqrt(jnp.mean(x32 * x32, axis=-1, keepdims=True) + EPS)
    return (y * gain.astype(jnp.float32)).astype(x.dtype)


def s5_mixer(u, a_re, a_im, log_dt, b_re, b_im, c_re, c_im, d_skip):
    bsz, seq, _ = u.shape
    f32 = jnp.float32
    ug = u.astype(f32).reshape(bsz, seq, S5_GROUPS, S5_GROUP)
    a_re = a_re.astype(f32); a_im = a_im.astype(f32)
    dt = jnp.exp(log_dt.astype(f32))[:, None]
    mag = jnp.exp(a_re * dt)
    ang = a_im * dt
    lb_re = mag * jnp.cos(ang)
    lb_im = mag * jnp.sin(ang)
    den = a_re * a_re + a_im * a_im
    n_re = lb_re - 1.0
    n_im = lb_im
    co_re = ((n_re * a_re + n_im * a_im) / den)[..., None]
    co_im = ((n_im * a_re - n_re * a_im) / den)[..., None]
    b_re = b_re.astype(f32); b_im = b_im.astype(f32)
    bb_re = co_re * b_re - co_im * b_im
    bb_im = co_re * b_im + co_im * b_re
    bu_re = jnp.einsum('bsgh,gph->bsgp', ug, bb_re)
    bu_im = jnp.einsum('bsgh,gph->bsgp', ug, bb_im)
    al_re = jnp.broadcast_to(lb_re, (1, seq, S5_GROUPS, S5_STATE))
    al_im = jnp.broadcast_to(lb_im, (1, seq, S5_GROUPS, S5_STATE))

    def combine(left, right):
        ar1, ai1, br1, bi1 = left
        ar2, ai2, br2, bi2 = right
        return (ar2 * ar1 - ai2 * ai1,
                ar2 * ai1 + ai2 * ar1,
                ar2 * br1 - ai2 * bi1 + br2,
                ar2 * bi1 + ai2 * br1 + bi2)

    _, _, x_re, x_im = lax.associative_scan(combine, (al_re, al_im, bu_re, bu_im), axis=1)
    y = (jnp.einsum('bsgp,ghp->bsgh', x_re, c_re.astype(f32))
         - jnp.einsum('bsgp,ghp->bsgh', x_im, c_im.astype(f32))
         + d_skip.astype(f32).reshape(S5_GROUPS, S5_GROUP) * ug)
    return y.reshape(bsz, seq, S5_WIDTH).astype(u.dtype)


def hgrn2_mixer(q, f_raw, i, g, lb, norm_gain):
    bsz, seq, _ = q.shape
    nc = seq // CHUNK
    f32 = jnp.float32
    lb = lb.astype(f32).reshape(HG_HEADS, HG_HEAD_DIM)
    f = lb + (1.0 - lb) * jax.nn.sigmoid(f_raw.astype(f32).reshape(bsz, seq, HG_HEADS, HG_HEAD_DIM))
    log_f = jnp.log(f)
    k = 1.0 - f
    qa = jax.nn.silu(q.astype(f32)) * (HG_HEAD_DIM ** -0.5)

    def blocks(t):
        return t.astype(f32).reshape(bsz, nc, CHUNK, HG_HEADS, HG_HEAD_DIM).transpose(1, 0, 2, 3, 4)

    causal = jnp.tril(jnp.ones((CHUNK, CHUNK), dtype=bool))[None, :, :, None, None]

    def step(state, xs):
        qc, kc, ic, lfc = xs
        bcum = jnp.cumsum(lfc, axis=1)
        o_inter = jnp.einsum('bthk,bhkv->bthv', qc * jnp.exp(bcum), state)
        decay = jnp.exp(jnp.where(causal, bcum[:, :, None] - bcum[:, None, :], -jnp.inf))
        scores = jnp.sum(qc[:, :, None] * kc[:, None, :] * decay, axis=-1)
        o_intra = jnp.einsum('btsh,bshv->bthv', scores, ic)
        b_last = bcum[:, -1]
        state = (jnp.exp(b_last)[..., None] * state
                 + jnp.einsum('bshk,bshv->bhkv', kc * jnp.exp(b_last[:, None] - bcum), ic))
        return state, o_inter + o_intra

    state0 = jnp.zeros((bsz, HG_HEADS, HG_HEAD_DIM, HG_HEAD_DIM), f32)
    _, o = lax.scan(step, state0, (blocks(qa), blocks(k), blocks(i), blocks(log_f)))
    o = o.transpose(1, 0, 2, 3, 4).reshape(bsz, seq, HG_HEADS, HG_HEAD_DIM)
    o = rmsnorm(o, norm_gain.reshape(HG_HEADS, HG_HEAD_DIM))
    o = o.reshape(bsz, seq, HG_WIDTH) * jax.nn.silu(g.astype(f32))
    return o.astype(q.dtype)


def conv_ffn(u, w_up, w_conv, b_conv, w_down):
    seq = u.shape[1]
    h = u @ w_up
    hp = jnp.pad(h, ((0, 0), (CONV_W - 1, 0), (0, 0)))
    hc = hp[:, 0:seq] * w_conv[0]
    for j in range(1, CONV_W):
        hc = hc + hp[:, j:j + seq] * w_conv[j]
    hc = hc + b_conv
    gate, val = jnp.split(hc, 2, axis=-1)
    return (jax.nn.silu(gate) * val) @ w_down


def setup_inputs(seed: int = 0) -> dict:
    key = jax.random.key(seed)
    ks = jax.random.split(key, 24)
    f32 = jnp.float32
    L = DEPTH
    nrm = lambda k, shp, s: jax.random.normal(k, shp, f32) * s
    x = jax.random.normal(ks[0], (BATCH, SEQ, D_MODEL), f32)
    g_mix = 1.0 + nrm(ks[1], (L, D_MODEL), 0.01)
    w_in = nrm(ks[2], (L, D_MODEL, N_IN), D_MODEL ** -0.5)
    s5_a_re = -0.5 * (1.0 + nrm(ks[3], (L, S5_GROUPS, S5_STATE), 0.02))
    s5_a_im = jnp.broadcast_to(jnp.pi * jnp.arange(S5_STATE, dtype=f32), (L, S5_GROUPS, S5_STATE)) + nrm(ks[4], (L, S5_GROUPS, S5_STATE), 0.01)
    s5_log_dt = jax.random.uniform(ks[5], (L, S5_GROUPS), f32, math.log(1e-3), math.log(1e-1))
    s5_b_re = nrm(ks[6], (L, S5_GROUPS, S5_STATE, S5_GROUP), (2 * S5_GROUP) ** -0.5)
    s5_b_im = nrm(ks[7], (L, S5_GROUPS, S5_STATE, S5_GROUP), (2 * S5_GROUP) ** -0.5)
    s5_c_re = nrm(ks[8], (L, S5_GROUPS, S5_GROUP, S5_STATE), (2 * S5_STATE) ** -0.5)
    s5_c_im = nrm(ks[9], (L, S5_GROUPS, S5_GROUP, S5_STATE), (2 * S5_STATE) ** -0.5)
    s5_d = nrm(ks[10], (L, S5_WIDTH), 1.0)
    w_glu = nrm(ks[11], (L, S5_WIDTH, S5_WIDTH), S5_WIDTH ** -0.5)
    b_glu = nrm(ks[12], (L, S5_WIDTH), 0.01)
    hg_lb_logits = nrm(ks[13], (L + 1, HG_WIDTH), 0.1)
    hg_norm_gain = 1.0 + nrm(ks[14], (L, HG_WIDTH), 0.01)
    w_pa = nrm(ks[15], (L, S5_WIDTH, D_MODEL), S5_WIDTH ** -0.5)
    w_pb = nrm(ks[16], (L, HG_WIDTH, D_MODEL), HG_WIDTH ** -0.5)
    w_out = nrm(ks[17], (L, D_MODEL, D_MODEL), D_MODEL ** -0.5)
    g_ffn = 1.0 + nrm(ks[18], (L, D_MODEL), 0.01)
    w_up = nrm(ks[19], (L, D_MODEL, 2 * D_FF), D_MODEL ** -0.5)
    w_conv = nrm(ks[20], (L, CONV_W, 2 * D_FF), CONV_W ** -0.5)
    b_conv = nrm(ks[21], (L, 2 * D_FF), 0.01)
    w_down = nrm(ks[22], (L, D_FF, D_MODEL), D_FF ** -0.5)
    g_final = 1.0 + nrm(ks[23], (D_MODEL,), 0.01)
    return {"x": x, "g_mix": g_mix, "w_in": w_in, "s5_a_re": s5_a_re, "s5_a_im": s5_a_im,
            "s5_log_dt": s5_log_dt, "s5_b_re": s5_b_re, "s5_b_im": s5_b_im, "s5_c_re": s5_c_re,
            "s5_c_im": s5_c_im, "s5_d": s5_d, "w_glu": w_glu, "b_glu": b_glu,
            "hg_lb_logits": hg_lb_logits, "hg_norm_gain": hg_norm_gain, "w_pa": w_pa, "w_pb": w_pb,
            "w_out": w_out, "g_ffn": g_ffn, "w_up": w_up, "w_conv": w_conv, "b_conv": b_conv,
            "w_down": w_down, "g_final": g_final}


def reference(x, g_mix, w_in, s5_a_re, s5_a_im, s5_log_dt, s5_b_re, s5_b_im, s5_c_re, s5_c_im,
              s5_d, w_glu, b_glu, hg_lb_logits, hg_norm_gain, w_pa, w_pb, w_out, g_ffn, w_up,
              w_conv, b_conv, w_down, g_final):
    lb_all = jnp.cumsum(jax.nn.softmax(hg_lb_logits.astype(jnp.float32), axis=0), axis=0)
    splits = [S5_WIDTH + j * HG_WIDTH for j in range(5)] + [S5_WIDTH + 4 * HG_WIDTH + D_MODEL]
    for l in range(DEPTH):
        u = rmsnorm(x, g_mix[l])
        z = u @ w_in[l]
        za, zq, zf, zi, zg, zga, zgb = jnp.split(z, splits, axis=-1)
        ya = s5_mixer(za, s5_a_re[l], s5_a_im[l], s5_log_dt[l], s5_b_re[l], s5_b_im[l],
                      s5_c_re[l], s5_c_im[l], s5_d[l])
        ya = jax.nn.gelu(ya)
        ya = ya * jax.nn.sigmoid(ya @ w_glu[l] + b_glu[l])
        yb = hgrn2_mixer(zq, zf, zi, zg, lb_all[l], hg_norm_gain[l])
        m = jax.nn.sigmoid(zga) * (ya @ w_pa[l]) + jax.nn.sigmoid(zgb) * (yb @ w_pb[l])
        x = x + m @ w_out[l]
        x = x + conv_ffn(rmsnorm(x, g_ffn[l]), w_up[l], w_conv[l], b_conv[l], w_down[l])
    return rmsnorm(x, g_final)
```

```cpp
#include <hip/hip_runtime.h>
#include <cstdio>
#include <cstdint>
#include <cmath>

typedef unsigned short bf16;
typedef float f32x4 __attribute__((ext_vector_type(4)));

constexpr int D_MODEL = 1024, BATCH = 16, SEQ = 2048, M = BATCH * SEQ;
constexpr int S5W = 512, S5G = 16, S5NG = 32, S5P = 64;
constexpr int HGW = 512, HGD = 128, HGH = 4;
constexpr int DFF = 2816, NUP = 2 * DFF;
constexpr int NIN = 4608;
constexpr float EPS = 1e-6f;
constexpr int UAK = 1152;

constexpr size_t MiB = 1u << 20;
constexpr size_t WS_SMALL = 30 * MiB;
constexpr size_t WS_XN = 118 * MiB;
constexpr size_t WS_ZQ = 182 * MiB, WS_LF = 214 * MiB, WS_ZI = 278 * MiB, WS_ZG = 310 * MiB, WS_UA = 342 * MiB, WS_GA = 378 * MiB, WS_GB = 442 * MiB;
constexpr size_t WS_T = 182 * MiB, WS_MM = 246 * MiB;
constexpr size_t WS_XG = 118 * MiB;
constexpr size_t WS_AF = 182 * MiB;
constexpr size_t WS_SS1 = 506 * MiB;
constexpr size_t WS_END = 512 * MiB;
constexpr size_t DO_YA = 0, DO_YB = 32 * MiB, DO_YA2 = 64 * MiB;

__device__ __forceinline__ float bf2f(bf16 v) { return __uint_as_float((unsigned)v << 16); }
__device__ __forceinline__ bf16 f2bf(float f) { unsigned u = __float_as_uint(f); return (bf16)((u + 0x7fffu + ((u >> 16) & 1u)) >> 16); }
__device__ __forceinline__ float sigmoidf_(float x) { return 1.f / (1.f + __expf(-x)); }
__device__ __forceinline__ float siluf_(float x) { return x / (1.f + __expf(-x)); }
__device__ __forceinline__ float gelu_tanh(float x) { const float u = 0.7978845608028654f * (x + 0.044715f * x * x * x); return 0.5f * x * (1.f + tanhf(u)); }

struct Bufs {
    const float* in[24]; float* out; unsigned char* ws;
};

__global__ void n_lb(const float* logits, float* LB) {
    const int c = blockIdx.x * blockDim.x + threadIdx.x;
    if (c < HGW) { const float l0 = logits[c], l1 = logits[HGW + c]; LB[c] = 1.f / (1.f + expf(l1 - l0)); }
}

__global__ __launch_bounds__(256) void n_rmsnorm_bf16(const float* x, const float* g, bf16* o) {
    const int row = blockIdx.x * 4 + (threadIdx.x >> 6), lane = threadIdx.x & 63;
    const float* xr = x + (size_t)row * D_MODEL;
    float v[16]; float s = 0.f;
#pragma unroll
    for (int j = 0; j < 16; ++j) { v[j] = xr[lane + 64 * j]; s += v[j] * v[j]; }
#pragma unroll
    for (int o_ = 1; o_ < 64; o_ <<= 1) s += __shfl_xor(s, o_);
    const float rstd = rsqrtf(s * (1.f / D_MODEL) + EPS);
#pragma unroll
    for (int j = 0; j < 16; ++j) o[(size_t)row * D_MODEL + lane + 64 * j] = f2bf(v[j] * rstd * g[lane + 64 * j]);
}

template <class Epi>
__global__ __launch_bounds__(256) void n_gemm(const bf16* A, int lda, const float* W, int ldw, int K, Epi epi) {
    __shared__ float As[16][68];
    __shared__ float Ws[16][64];
    const int t = threadIdx.x, tx = t & 15, ty = t >> 4;
    const int row0 = blockIdx.y * 64, col0 = blockIdx.x * 64;
    float acc[4][4];
#pragma unroll
    for (int i = 0; i < 4; ++i)
#pragma unroll
        for (int j = 0; j < 4; ++j) acc[i][j] = 0.f;
    for (int k0 = 0; k0 < K; k0 += 16) {
        { const int r = t >> 2, kk = (t & 3) * 4; const bf16* ap = A + (size_t)(row0 + r) * lda + k0 + kk;
#pragma unroll
          for (int q = 0; q < 4; ++q) As[kk + q][r] = bf2f(ap[q]); }
        { const int kk = t >> 4, c = (t & 15) * 4; const f32x4 w = *(const f32x4*)(W + (size_t)(k0 + kk) * ldw + col0 + c);
          Ws[kk][c] = w.x; Ws[kk][c + 1] = w.y; Ws[kk][c + 2] = w.z; Ws[kk][c + 3] = w.w; }
        __syncthreads();
#pragma unroll
        for (int kk = 0; kk < 16; ++kk) {
            float a[4], b[4];
#pragma unroll
            for (int i = 0; i < 4; ++i) a[i] = As[kk][ty * 4 + i];
#pragma unroll
            for (int j = 0; j < 4; ++j) b[j] = Ws[kk][tx * 4 + j];
#pragma unroll
            for (int i = 0; i < 4; ++i)
#pragma unroll
                for (int j = 0; j < 4; ++j) acc[i][j] += a[i] * b[j];
        }
        __syncthreads();
    }
#pragma unroll
    for (int i = 0; i < 4; ++i)
#pragma unroll
        for (int j = 0; j < 4; ++j) epi(row0 + ty * 4 + i, col0 + tx * 4 + j, acc[i][j]);
}

struct EpiP1 {
    bf16 *UA, *Zq, *Zi, *Zg, *Ga, *Gb; float* LF; const float* LB;
    __device__ void operator()(int row, int col, float v) const {
        if (col < 512) { const int g = col >> 4, h = col & 15; UA[((size_t)g * 512 + (row >> 6)) * UAK + (row & 63) * 16 + h] = f2bf(v); }
        else if (col < 1024) { Zq[(size_t)row * 512 + col - 512] = f2bf(siluf_(v) * 0.08838834764831845f); }
        else if (col < 1536) { const int c = col - 1024; const float lb = LB[c]; const float f = lb + (1.f - lb) * sigmoidf_(v); LF[(size_t)row * 512 + c] = logf(f); }
        else if (col < 2048) { Zi[(size_t)row * 512 + col - 1536] = f2bf(v); }
        else if (col < 2560) { Zg[(size_t)row * 512 + col - 2048] = f2bf(siluf_(v)); }
        else if (col < 3584) { Ga[(size_t)row * 1024 + col - 2560] = f2bf(sigmoidf_(v)); }
        else { Gb[(size_t)row * 1024 + col - 3584] = f2bf(sigmoidf_(v)); }
    }
};

__global__ __launch_bounds__(64) void n_s5(const bf16* UA, const float* a_re, const float* a_im, const float* log_dt, const float* b_re, const float* b_im,
                                            const float* c_re, const float* c_im, const float* dsk, bf16* YA) {
    __shared__ float cs[2][16][65];
    __shared__ float xs[2][64];
    const int b = blockIdx.x >> 5, g = blockIdx.x & 31, p = threadIdx.x;
    const double dt = exp((double)log_dt[g]);
    const double ar = a_re[g * 64 + p], ai = a_im[g * 64 + p];
    const double mag = exp(ar * dt), ang = ai * dt;
    const double lr = mag * cos(ang), li = mag * sin(ang);
    const double den = ar * ar + ai * ai, nr = lr - 1.0, ni = li;
    const double cor = (nr * ar + ni * ai) / den, coi = (ni * ar - nr * ai) / den;
    float bbr[16], bbi[16];
#pragma unroll
    for (int h = 0; h < 16; ++h) { const double br = b_re[(g * 64 + p) * 16 + h], bi = b_im[(g * 64 + p) * 16 + h]; bbr[h] = (float)(cor * br - coi * bi); bbi[h] = (float)(cor * bi + coi * br); }
    for (int h = 0; h < 16; ++h) { cs[0][h][p] = c_re[(g * 16 + h) * 64 + p]; cs[1][h][p] = c_im[(g * 16 + h) * 64 + p]; }
    const float lrf = (float)lr, lif = (float)li;
    float xr = 0.f, xi = 0.f;
    const int hh = p & 15, qq = p >> 4;
    const float dh = dsk[g * 16 + hh];
    __syncthreads();
    for (int t = 0; t < SEQ; ++t) {
        const bf16* up = UA + ((size_t)g * 512 + b * 32 + (t >> 6)) * UAK + (t & 63) * 16;
        float u[16];
#pragma unroll
        for (int h = 0; h < 16; ++h) u[h] = bf2f(up[h]);
        float br = 0.f, bi = 0.f;
#pragma unroll
        for (int h = 0; h < 16; ++h) { br += bbr[h] * u[h]; bi += bbi[h] * u[h]; }
        const float nxr = lrf * xr - lif * xi + br, nxi = lrf * xi + lif * xr + bi;
        xr = nxr; xi = nxi;
        xs[0][p] = xr; xs[1][p] = xi;
        __syncthreads();
        float y = 0.f;
#pragma unroll
        for (int q = 0; q < 16; ++q) { const int pp = qq * 16 + q; y += xs[0][pp] * cs[0][hh][pp] - xs[1][pp] * cs[1][hh][pp]; }
        y += __shfl_xor(y, 16); y += __shfl_xor(y, 32);
        if (qq == 0) { y += dh * u[hh]; YA[(size_t)(b * SEQ + t) * 512 + g * 16 + hh] = f2bf(gelu_tanh(y)); }
        __syncthreads();
    }
}

__global__ __launch_bounds__(256) void n_hgrn(const bf16* Zq, const float* LF, const bf16* Zi, float* Oraw) {
    __shared__ float qs[2][128], fs[2][128], is[2][32], red[8][32];
    const int vq = blockIdx.x & 3, h = (blockIdx.x >> 2) & 3, b = blockIdx.x >> 4;
    const int tid = threadIdx.x, kg = tid >> 5, v = tid & 31;
    float S[16];
#pragma unroll
    for (int j = 0; j < 16; ++j) S[j] = 0.f;
    for (int t = 0; t < SEQ; ++t) {
        const size_t row = (size_t)b * SEQ + t; const int bb = t & 1;
        if (tid < 128) { qs[bb][tid] = bf2f(Zq[row * 512 + h * 128 + tid]); fs[bb][tid] = __expf(LF[row * 512 + h * 128 + tid]); }
        else if (tid < 160) is[bb][tid - 128] = bf2f(Zi[row * 512 + h * 128 + vq * 32 + tid - 128]);
        __syncthreads();
        const float iv = is[bb][v]; float part = 0.f;
#pragma unroll
        for (int j = 0; j < 16; ++j) { const float f = fs[bb][kg * 16 + j]; S[j] = f * S[j] + (1.f - f) * iv; part += S[j] * qs[bb][kg * 16 + j]; }
        red[kg][v] = part;
        __syncthreads();
        if (kg == 0) { float o = 0.f;
#pragma unroll
            for (int q = 0; q < 8; ++q) o += red[q][v];
            Oraw[row * 512 + h * 128 + vq * 32 + v] = o; }
    }
}
__global__ __launch_bounds__(256) void n_hgnorm(const float* Oraw, const bf16* Zg, const float* gain, bf16* YB) {
    const int w = blockIdx.x * 4 + (threadIdx.x >> 6), lane = threadIdx.x & 63;
    const int row = w >> 2, h = w & 3;
    const size_t base = (size_t)row * 512 + h * 128;
    const float o0 = Oraw[base + lane], o1 = Oraw[base + 64 + lane];
    float s = o0 * o0 + o1 * o1;
#pragma unroll
    for (int o_ = 1; o_ < 64; o_ <<= 1) s += __shfl_xor(s, o_);
    const float rstd = rsqrtf(s * (1.f / 128.f) + EPS);
    YB[base + lane] = f2bf(o0 * rstd * gain[h * 128 + lane] * bf2f(Zg[base + lane]));
    YB[base + 64 + lane] = f2bf(o1 * rstd * gain[h * 128 + 64 + lane] * bf2f(Zg[base + 64 + lane]));
}

struct EpiGlu { const bf16* YA; const float* bias; bf16* YA2;
    __device__ void operator()(int row, int col, float v) const { const size_t i = (size_t)row * 512 + col; YA2[i] = f2bf(bf2f(YA[i]) * sigmoidf_(v + bias[col])); } };
struct EpiT { const bf16* Gb; bf16* T;
    __device__ void operator()(int row, int col, float v) const { const size_t i = (size_t)row * 1024 + col; T[i] = f2bf(bf2f(Gb[i]) * v); } };
struct EpiM { const bf16* Ga; const bf16* T; bf16* Mm;
    __device__ void operator()(int row, int col, float v) const { const size_t i = (size_t)row * 1024 + col; Mm[i] = f2bf(bf2f(T[i]) + bf2f(Ga[i]) * v); } };
struct EpiOut { const float* x; const float* g; float* X1; bf16* XG;
    __device__ void operator()(int row, int col, float v) const { const size_t i = (size_t)row * 1024 + col; const float x1 = x[i] + v; X1[i] = x1; XG[i] = f2bf(x1 * g[col]); } };
struct EpiDown { float* X;
    __device__ void operator()(int row, int col, float v) const { const size_t i = (size_t)row * 1024 + col; X[i] = X[i] + v; } };

__global__ __launch_bounds__(256) void n_rowss(const float* x, float* SS) {
    const int row = blockIdx.x * 4 + (threadIdx.x >> 6), lane = threadIdx.x & 63;
    const float* xr = x + (size_t)row * D_MODEL; float s = 0.f;
#pragma unroll
    for (int j = 0; j < 16; ++j) { const float v = xr[lane + 64 * j]; s += v * v; }
#pragma unroll
    for (int o_ = 1; o_ < 64; o_ <<= 1) s += __shfl_xor(s, o_);
    if (lane < 16) SS[(size_t)row * 16 + lane] = lane == 0 ? s : 0.f;
}

__global__ __launch_bounds__(256) void n_ffn_up(const bf16* XG, const float* SS, const float* W, const float* wc, const float* bc, bf16* AF) {
    __shared__ float As[16][68];
    __shared__ float Ws[16][64];
    const int t = threadIdx.x, tx = t & 15, ty = t >> 4;
    const int row0 = blockIdx.y * 64, f0 = blockIdx.x * 32;
    float acc[6][4];
#pragma unroll
    for (int i = 0; i < 6; ++i)
#pragma unroll
        for (int j = 0; j < 4; ++j) acc[i][j] = 0.f;
    for (int k0 = 0; k0 < D_MODEL; k0 += 16) {
        for (int e = t; e < 66 * 16; e += 256) { const int r = e >> 4, kk = e & 15; int gr = row0 - 2 + r; if (gr < 0) gr = 0; As[kk][r] = bf2f(XG[(size_t)gr * D_MODEL + k0 + kk]); }
        { const int kk = t >> 4, c = (t & 15) * 4; const int colg = (c < 32) ? (f0 + c) : (DFF + f0 + c - 32); const f32x4 w = *(const f32x4*)(W + (size_t)(k0 + kk) * NUP + colg);
          Ws[kk][c] = w.x; Ws[kk][c + 1] = w.y; Ws[kk][c + 2] = w.z; Ws[kk][c + 3] = w.w; }
        __syncthreads();
#pragma unroll
        for (int kk = 0; kk < 16; ++kk) {
            float a[6], b[4];
#pragma unroll
            for (int i = 0; i < 6; ++i) a[i] = As[kk][ty * 4 + i];
            b[0] = Ws[kk][tx * 2]; b[1] = Ws[kk][tx * 2 + 1]; b[2] = Ws[kk][32 + tx * 2]; b[3] = Ws[kk][32 + tx * 2 + 1];
#pragma unroll
            for (int i = 0; i < 6; ++i)
#pragma unroll
                for (int j = 0; j < 4; ++j) acc[i][j] += a[i] * b[j];
        }
        __syncthreads();
    }
    float rs[6];
#pragma unroll
    for (int i = 0; i < 6; ++i) { int gr = row0 + 4 * ty - 2 + i; if (gr < 0) gr = 0; float s = 0.f;
#pragma unroll
        for (int q = 0; q < 16; ++q) s += SS[(size_t)gr * 16 + q];
        rs[i] = rsqrtf(s * (1.f / D_MODEL) + EPS); }
#pragma unroll
    for (int i = 0; i < 4; ++i) {
        const int row = row0 + 4 * ty + i, tt = row & (SEQ - 1);
#pragma unroll
        for (int j = 0; j < 2; ++j) {
            const int ff = f0 + tx * 2 + j;
            float hg = bc[ff], hv = bc[DFF + ff];
#pragma unroll
            for (int q = 0; q < 3; ++q) if (tt - 2 + q >= 0) { hg += wc[q * NUP + ff] * acc[i + q][j] * rs[i + q]; hv += wc[q * NUP + DFF + ff] * acc[i + q][2 + j] * rs[i + q]; }
            AF[(size_t)row * DFF + ff] = f2bf(siluf_(hg) * hv);
        }
    }
}

__global__ __launch_bounds__(256) void n_final(float* x, const float* g) {
    const int row = blockIdx.x * 4 + (threadIdx.x >> 6), lane = threadIdx.x & 63;
    float* xr = x + (size_t)row * D_MODEL;
    float v[16]; float s = 0.f;
#pragma unroll
    for (int j = 0; j < 16; ++j) { v[j] = xr[lane + 64 * j]; s += v[j] * v[j]; }
#pragma unroll
    for (int o_ = 1; o_ < 64; o_ <<= 1) s += __shfl_xor(s, o_);
    const float rstd = rsqrtf(s * (1.f / D_MODEL) + EPS);
#pragma unroll
    for (int j = 0; j < 16; ++j) xr[lane + 64 * j] = v[j] * rstd * g[lane + 64 * j];
}

#define LAS __attribute__((address_space(3)))
#define GAS __attribute__((address_space(1)))
typedef short bf16x8 __attribute__((ext_vector_type(8)));
typedef unsigned u32x4 __attribute__((ext_vector_type(4)));
typedef unsigned u32x2 __attribute__((ext_vector_type(2)));
typedef float f32x2 __attribute__((ext_vector_type(2)));

constexpr int NWAVES = 8;
constexpr int RING_BYTES = 131072, EPI_OFF = RING_BYTES, EPI_BYTES = 16384, LDS_BYTES = RING_BYTES + EPI_BYTES;

constexpr size_t WS_W_IN = 0, WS_W_GLU = 9 * MiB, WS_W_PA = WS_W_GLU + MiB / 2, WS_W_PB = WS_W_PA + MiB, WS_W_OUT = WS_W_PB + MiB, WS_W_UP = WS_W_OUT + 2 * MiB, WS_W_DN = WS_W_UP + 11 * MiB;
static_assert(WS_W_DN + (size_t)1024 * DFF * 2 <= 30 * MiB, "weights");
constexpr size_t WS_CTL = 30 * MiB + 65536;
constexpr size_t WS_PM = 31 * MiB, WS_DEC = 39 * MiB, WS_BT = 46 * MiB;
constexpr size_t WS_SS2 = 508 * MiB;
constexpr size_t WS_HF = 400 * MiB, WS_HL = 406 * MiB;

typedef __bf16 bf16x2_t __attribute__((ext_vector_type(2)));
__device__ __forceinline__ unsigned cvt_pk_bf16(float lo, float hi) { f32x2 v = {lo, hi}; bf16x2_t b = __builtin_convertvector(v, bf16x2_t); return __builtin_bit_cast(unsigned, b); }
__device__ __forceinline__ u32x4 pack8(f32x4 a, f32x4 b) { u32x4 w; w.x = cvt_pk_bf16(a[0], a[1]); w.y = cvt_pk_bf16(a[2], a[3]); w.z = cvt_pk_bf16(b[0], b[1]); w.w = cvt_pk_bf16(b[2], b[3]); return w; }
__device__ __forceinline__ void unpack8(u32x4 w, f32x4& a, f32x4& b) {
    a[0] = __uint_as_float(w.x << 16); a[1] = __uint_as_float(w.x & 0xffff0000u); a[2] = __uint_as_float(w.y << 16); a[3] = __uint_as_float(w.y & 0xffff0000u);
    b[0] = __uint_as_float(w.z << 16); b[1] = __uint_as_float(w.z & 0xffff0000u); b[2] = __uint_as_float(w.w << 16); b[3] = __uint_as_float(w.w & 0xffff0000u); }
__device__ __forceinline__ float fsig(float x) { return __builtin_amdgcn_rcpf(1.f + __expf(-x)); }
__device__ __forceinline__ f32x4 fsig4(f32x4 x) { f32x4 r; r[0] = fsig(x[0]); r[1] = fsig(x[1]); r[2] = fsig(x[2]); r[3] = fsig(x[3]); return r; }
__device__ __forceinline__ float fgelu(float x) { const float u2 = 1.5957691216057308f * (x + 0.044715f * x * x * x); return x * fsig(u2); }

namespace pg8 {
constexpr int BM = 256, BK = 64, HALF = 128, HTB = HALF * BK * 2  , NXCD = 8, WGM = 8;
__host__ __device__ __forceinline__ int lds_byte(int r, int c) { const int st = (r >> 4) * 2 + (c >> 5), rr = r & 15, cc = c & 31, ob = rr * 64 + cc * 2; return st * 1024 + (ob ^ (((ob >> 9) & 1) << 5)); }
__host__ __device__ __forceinline__ void stage_rc(int b, int& R, int& C) { const int st = b / 1024, sb = b % 1024, swz = sb ^ (((sb >> 9) & 1) << 5); R = (st >> 1) * 16 + swz / 64; C = (st & 1) * 32 + (swz % 64) / 2; }
__host__ __device__ __forceinline__ int perm32(int rho) { const int n = rho >> 4, i = rho & 15; return 8 * (i >> 2) + 4 * n + (i & 3); }

struct Unit { int pm, pn, pz; };
struct Gemm { const char* A; const char* B; unsigned lda, ldb; long a_pm, a_pz, b_pn, b_pz, hsA, hsB; int nt; };
__device__ __forceinline__ Gemm plain_gemm(const void* A, int lda_el, const void* Bt, int K) {
    Gemm g; g.A = (const char*)A; g.B = (const char*)Bt; g.lda = (unsigned)lda_el * 2u; g.ldb = (unsigned)K * 2u; g.a_pm = 256L * lda_el * 2; g.a_pz = 0; g.b_pn = 256L * K * 2; g.b_pz = 0;
    g.hsA = 128L * lda_el * 2; g.hsB = 128L * K * 2; g.nt = K / BK; return g; }

struct StaticOrder {
    int nM, nN, nwg, G, c;
    __device__ void init(int Mr, int N, int G_, int c_) { nM = Mr / BM; nN = N / BM; nwg = nM * nN; G = G_; c = c_; }
    __device__ bool next(int i, Unit& u) const {
        const long L = (long)i * G + c; if (L >= nwg) return false;
        int wgid = (int)L; { const int q = nwg / NXCD, r = nwg % NXCD, xcd = wgid % NXCD, off = wgid / NXCD; wgid = (xcd < r ? xcd * (q + 1) : r * (q + 1) + (xcd - r) * q) + off; }
        const int nig = WGM * nN, gid = wgid / nig, fm = gid * WGM, gsz = (nM - fm) < WGM ? (nM - fm) : WGM;
        u.pm = fm + ((wgid % nig) % gsz); u.pn = (wgid % nig) / gsz; u.pz = 0; return true;
    }
};

template <class Epi, class Sched>
__device__ __forceinline__ void gemm_phase(LAS unsigned char* lds, LAS unsigned char* es, const Gemm g, const Sched& S, const Epi& E) {
    const int tid = threadIdx.x, wid = __builtin_amdgcn_readfirstlane(tid >> 6), lane = tid & 63, wr = wid >> 2, wc = wid & 3, fr = lane & 15, fq = lane >> 4;
    const int nt = g.nt;
    unsigned voffA[2], voffB[2];
#pragma unroll
    for (int i = 0; i < 2; ++i) { int R, C; stage_rc(tid * 16 + i * 8192, R, C); const int Rb = Epi::PERM ? ((R & ~31) + perm32(R & 31)) : R;
        voffA[i] = (unsigned)R * g.lda + (unsigned)C * 2u; voffB[i] = (unsigned)Rb * g.ldb + (unsigned)C * 2u; }
    const size_t kstep = (size_t)(BK * 2);
    const long hsA = g.hsA, hsB = g.hsB;
    const unsigned ldsw = (unsigned)wid * 1024u;
    const int aoff = lds_byte(wr * 64 + fr, fq * 8), boff = lds_byte(wc * 32 + fr, fq * 8);
#define PG8_SA(b, h) (((b) * 2 + (h)) * HTB)
#define PG8_SB(b, h) ((4 + (b) * 2 + (h)) * HTB)
#define PG8_STAGE(bufoff, gbase, voff) do { _Pragma("unroll") for (int _i = 0; _i < 2; ++_i) \
        __builtin_amdgcn_global_load_lds((const unsigned*)((const char*)(gbase) + (voff)[_i]), (LAS unsigned*)(lds + (bufoff) + ldsw + _i * 8192), 16, 0, 0); } while (0)
#define PG8_LDA(dst, b, h) do { _Pragma("unroll") for (int m = 0; m < 4; ++m) _Pragma("unroll") for (int k = 0; k < 2; ++k) dst[m][k] = *(const LAS bf16x8*)(lds + PG8_SA(b, h) + aoff + m * 2048 + k * 1024); } while (0)
#define PG8_LDB(dst, b, h) do { _Pragma("unroll") for (int n = 0; n < 2; ++n) _Pragma("unroll") for (int k = 0; k < 2; ++k) dst[n][k] = *(const LAS bf16x8*)(lds + PG8_SB(b, h) + boff + n * 2048 + k * 1024); } while (0)
#define PG8_MMA(ai, bj, At, Bt) do { __builtin_amdgcn_s_setprio(1); _Pragma("unroll") for (int m = 0; m < 4; ++m) _Pragma("unroll") for (int n = 0; n < 2; ++n) _Pragma("unroll") for (int k = 0; k < 2; ++k) \
        acc[ai][bj][m][n] = __builtin_amdgcn_mfma_f32_16x16x32_bf16(Bt[n][k], At[m][k], acc[ai][bj][m][n], 0, 0, 0); __builtin_amdgcn_s_setprio(0); } while (0)
#define PG8_WAIT_V(n) asm volatile("s_waitcnt vmcnt(" #n ")" ::: "memory")
#define PG8_WAIT_L(n) asm volatile("s_waitcnt lgkmcnt(" #n ")" ::: "memory")
#define PG8_BAR __builtin_amdgcn_s_barrier()
#define PG8_SCHED __builtin_amdgcn_sched_barrier(0)
    Unit cur, nxt; int ui = 0;
    if (!S.next(0, cur)) return;
    f32x4 acc[2][2][4][2];
#pragma unroll
    for (int a = 0; a < 2; ++a)
#pragma unroll
        for (int b = 0; b < 2; ++b)
#pragma unroll
            for (int m = 0; m < 4; ++m)
#pragma unroll
                for (int n = 0; n < 2; ++n) acc[a][b][m][n] = (f32x4){0.f, 0.f, 0.f, 0.f};
    bf16x8 At[4][2], B0[2][2], B1[2][2];
    const char* cA = g.A + (long)cur.pm * g.a_pm + (long)cur.pz * g.a_pz; const char* cB = g.B + (long)cur.pn * g.b_pn + (long)cur.pz * g.b_pz;
    PG8_STAGE(PG8_SB(0, 0), cB, voffB); PG8_STAGE(PG8_SB(0, 1), cB + hsB, voffB); PG8_STAGE(PG8_SA(0, 0), cA, voffA); PG8_STAGE(PG8_SA(0, 1), cA + hsA, voffA);
    if (wr == 1) PG8_BAR;
    PG8_WAIT_V(2); PG8_BAR;
    PG8_STAGE(PG8_SB(1, 0), cB + kstep, voffB); PG8_STAGE(PG8_SA(1, 0), cA + kstep, voffA); PG8_STAGE(PG8_SB(1, 1), cB + hsB + kstep, voffB);
    PG8_WAIT_V(6); PG8_BAR;
    for (;;) {
        const bool has_next = S.next(ui + 1, nxt);
        const char* nA = has_next ? g.A + (long)nxt.pm * g.a_pm + (long)nxt.pz * g.a_pz : cA; const char* nB = has_next ? g.B + (long)nxt.pn * g.b_pn + (long)nxt.pz * g.b_pz : cB;
        for (int t = 0; t < nt; t += 2) {
            const bool last = (t == nt - 2);
            const char* a1 = cA + (size_t)(t + 1) * kstep;
            const char* a2 = last ? nA : cA + (size_t)(t + 2) * kstep; const char* b2 = last ? nB : cB + (size_t)(t + 2) * kstep;
            const char* a3 = a2 + kstep; const char* b3 = b2 + kstep;
            PG8_LDB(B0, 0, 0); PG8_LDB(B1, 0, 1); PG8_SCHED; PG8_LDA(At, 0, 0); PG8_STAGE(PG8_SA(1, 1), a1 + hsA, voffA);
            PG8_WAIT_V(8); PG8_WAIT_L(0); PG8_BAR; PG8_MMA(0, 0, At, B0); PG8_MMA(0, 1, At, B1); PG8_BAR; PG8_SCHED;
            PG8_LDA(At, 0, 1); PG8_STAGE(PG8_SB(0, 0), b2, voffB); PG8_STAGE(PG8_SB(0, 1), b2 + hsB, voffB); PG8_STAGE(PG8_SA(0, 0), a2, voffA);
            PG8_WAIT_V(8); PG8_WAIT_L(0); PG8_BAR; PG8_MMA(1, 0, At, B0); PG8_MMA(1, 1, At, B1); PG8_BAR; PG8_SCHED;
            PG8_LDB(B0, 1, 0); PG8_LDB(B1, 1, 1); PG8_SCHED; PG8_LDA(At, 1, 0); PG8_STAGE(PG8_SA(0, 1), a2 + hsA, voffA);
            PG8_WAIT_V(8); PG8_WAIT_L(0); PG8_BAR; PG8_MMA(0, 0, At, B0); PG8_MMA(0, 1, At, B1); PG8_BAR; PG8_SCHED;
            PG8_LDA(At, 1, 1); PG8_STAGE(PG8_SB(1, 0), b3, voffB); PG8_STAGE(PG8_SB(1, 1), b3 + hsB, voffB); PG8_STAGE(PG8_SA(1, 0), a3, voffA);
            PG8_WAIT_V(8); PG8_WAIT_L(0); PG8_BAR; PG8_MMA(1, 0, At, B0); PG8_MMA(1, 1, At, B1); PG8_BAR; PG8_SCHED;
        }
        if (wr == 0) PG8_BAR;
        E(acc, cur, wr, wc, fr, fq, wid, lane, es);
        if (!has_next) break;
#pragma unroll
        for (int a = 0; a < 2; ++a)
#pragma unroll
            for (int b = 0; b < 2; ++b)
#pragma unroll
                for (int m = 0; m < 4; ++m)
#pragma unroll
                    for (int n = 0; n < 2; ++n) acc[a][b][m][n] = (f32x4){0.f, 0.f, 0.f, 0.f};
        cur = nxt; cA = nA; cB = nB; ++ui;
        if (wr == 1) PG8_BAR;
    }
    PG8_WAIT_V(0);
    PG8_BAR;
#undef PG8_SA
#undef PG8_SB
#undef PG8_STAGE
#undef PG8_LDA
#undef PG8_LDB
#undef PG8_MMA
#undef PG8_WAIT_V
#undef PG8_WAIT_L
#undef PG8_BAR
#undef PG8_SCHED
}
}

using pg8::Unit;
#define EPI_ARGS f32x4 (&acc)[2][2][4][2], const Unit& u, int wr, int wc, int fr, int fq, int wid, int lane, LAS unsigned char* es
#define FOR_AI_M _Pragma("unroll") for (int ai = 0; ai < 2; ++ai) _Pragma("unroll") for (int m = 0; m < 4; ++m)
#define FOR_BJ _Pragma("unroll") for (int bj = 0; bj < 2; ++bj)

template <int ACT> __device__ __forceinline__ f32x4 act4(f32x4 x) {
    if (ACT == 1) { f32x4 r; _Pragma("unroll") for (int e = 0; e < 4; ++e) r[e] = x[e] * fsig(x[e]) * 0.08838834764831845f; return r; }
    if (ACT == 2) { f32x4 r; _Pragma("unroll") for (int e = 0; e < 4; ++e) r[e] = x[e] * fsig(x[e]); return r; }
    if (ACT == 3) return fsig4(x);
    return x;
}
template <int ACT> __device__ __forceinline__ void store_tile_bf16(const f32x4 (&acc)[2][2][4][2], bf16* dst, int ld, int rowb, int colb) {
    FOR_AI_M { bf16* rp = dst + (size_t)(rowb + ai * 128 + m * 16) * ld + colb;
        FOR_BJ *(u32x4*)(rp + bj * 128) = pack8(act4<ACT>(acc[ai][bj][m][0]), act4<ACT>(acc[ai][bj][m][1])); }
}
struct EpiP1f { static constexpr bool PERM = true;
    bf16 *UA, *Zq, *Zi, *Zg, *Ga, *Gb; float* LF; const float* LB;
    __device__ __forceinline__ void operator()(EPI_ARGS) const {
        const int rowb = u.pm * 256 + wr * 64 + fr, cb = wc * 32 + 8 * fq, pn = u.pn;
        if (pn < 2) {
            FOR_AI_M { const int row = rowb + ai * 128 + m * 16;
                FOR_BJ { const int col = pn * 256 + bj * 128 + cb; const int g = col >> 4, h0 = col & 15;
                    *(u32x4*)(UA + ((size_t)g * 512 + (row >> 6)) * UAK + (row & 63) * 16 + h0) = pack8(acc[ai][bj][m][0], acc[ai][bj][m][1]); } }
        } else if (pn < 4) store_tile_bf16<1>(acc, Zq, 512, rowb, (pn - 2) * 256 + cb);
        else if (pn < 6) {
            const int c0 = (pn - 4) * 256 + cb;
            f32x4 lb[2][2];
            FOR_BJ { lb[bj][0] = *(const f32x4*)(LB + c0 + bj * 128); lb[bj][1] = *(const f32x4*)(LB + c0 + bj * 128 + 4); }
            FOR_AI_M { float* rp = LF + (size_t)(rowb + ai * 128 + m * 16) * 512 + c0;
                FOR_BJ { _Pragma("unroll") for (int n = 0; n < 2; ++n) { f32x4 o; const f32x4 x = acc[ai][bj][m][n];
                    _Pragma("unroll") for (int e = 0; e < 4; ++e) { const float l = lb[bj][n][e]; o[e] = __logf(l + (1.f - l) * fsig(x[e])); }
                    *(f32x4*)(rp + bj * 128 + 4 * n) = o; } } }
        } else if (pn < 8) store_tile_bf16<0>(acc, Zi, 512, rowb, (pn - 6) * 256 + cb);
        else if (pn < 10) store_tile_bf16<2>(acc, Zg, 512, rowb, (pn - 8) * 256 + cb);
        else if (pn < 14) store_tile_bf16<3>(acc, Ga, 1024, rowb, (pn - 10) * 256 + cb);
        else store_tile_bf16<3>(acc, Gb, 1024, rowb, (pn - 14) * 256 + cb);
    }
};
struct EpiGluf { static constexpr bool PERM = true; const bf16* YA; const float* bias; bf16* YA2;
    __device__ __forceinline__ void operator()(EPI_ARGS) const {
        const int rowb = u.pm * 256 + wr * 64 + fr, cb = u.pn * 256 + wc * 32 + 8 * fq;
        f32x4 bv[2][2]; FOR_BJ { bv[bj][0] = *(const f32x4*)(bias + cb + bj * 128); bv[bj][1] = *(const f32x4*)(bias + cb + bj * 128 + 4); }
        FOR_AI_M { const size_t o = (size_t)(rowb + ai * 128 + m * 16) * 512 + cb;
            FOR_BJ { f32x4 a0, a1; unpack8(*(const u32x4*)(YA + o + bj * 128), a0, a1);
                *(u32x4*)(YA2 + o + bj * 128) = pack8(a0 * fsig4(acc[ai][bj][m][0] + bv[bj][0]), a1 * fsig4(acc[ai][bj][m][1] + bv[bj][1])); } }
    }
};
struct EpiTf { static constexpr bool PERM = true; const bf16* Gb; bf16* T;
    __device__ __forceinline__ void operator()(EPI_ARGS) const {
        const int rowb = u.pm * 256 + wr * 64 + fr, cb = u.pn * 256 + wc * 32 + 8 * fq;
        FOR_AI_M { const size_t o = (size_t)(rowb + ai * 128 + m * 16) * 1024 + cb;
            FOR_BJ { f32x4 a0, a1; unpack8(*(const u32x4*)(Gb + o + bj * 128), a0, a1); *(u32x4*)(T + o + bj * 128) = pack8(a0 * acc[ai][bj][m][0], a1 * acc[ai][bj][m][1]); } }
    }
};
struct EpiMf { static constexpr bool PERM = true; const bf16* Ga; const bf16* T; bf16* Mm;
    __device__ __forceinline__ void operator()(EPI_ARGS) const {
        const int rowb = u.pm * 256 + wr * 64 + fr, cb = u.pn * 256 + wc * 32 + 8 * fq;
        FOR_AI_M { const size_t o = (size_t)(rowb + ai * 128 + m * 16) * 1024 + cb;
            FOR_BJ { f32x4 a0, a1, t0, t1; unpack8(*(const u32x4*)(Ga + o + bj * 128), a0, a1); unpack8(*(const u32x4*)(T + o + bj * 128), t0, t1);
                *(u32x4*)(Mm + o + bj * 128) = pack8(t0 + a0 * acc[ai][bj][m][0], t1 + a1 * acc[ai][bj][m][1]); } }
    }
};
struct EpiOutf { static constexpr bool PERM = true; const float* x; const float* g; float* X1; bf16* XG; float* SS;
    __device__ __forceinline__ void operator()(EPI_ARGS) const {
        const int rowb = u.pm * 256 + wr * 64 + fr, cb = u.pn * 256 + wc * 32 + 8 * fq;
        f32x4 gv[2][2]; FOR_BJ { gv[bj][0] = *(const f32x4*)(g + cb + bj * 128); gv[bj][1] = *(const f32x4*)(g + cb + bj * 128 + 4); }
        FOR_AI_M { const int row = rowb + ai * 128 + m * 16; const size_t o = (size_t)row * 1024 + cb; float s = 0.f;
            FOR_BJ { const f32x4 x0 = *(const f32x4*)(x + o + bj * 128) + acc[ai][bj][m][0], x1 = *(const f32x4*)(x + o + bj * 128 + 4) + acc[ai][bj][m][1];
                *(f32x4*)(X1 + o + bj * 128) = x0; *(f32x4*)(X1 + o + bj * 128 + 4) = x1;
                *(u32x4*)(XG + o + bj * 128) = pack8(x0 * gv[bj][0], x1 * gv[bj][1]);
                s += (x0[0] * x0[0] + x0[1] * x0[1]) + (x0[2] * x0[2] + x0[3] * x0[3]) + (x1[0] * x1[0] + x1[1] * x1[1]) + (x1[2] * x1[2] + x1[3] * x1[3]); }
            s += __shfl_xor(s, 16); s += __shfl_xor(s, 32);
            if (fq == 0) SS[(size_t)row * 16 + u.pn * 4 + wc] = s; }
    }
};
struct EpiDownf { static constexpr bool PERM = true; float* X; float* SS;
    __device__ __forceinline__ void operator()(EPI_ARGS) const {
        const int rowb = u.pm * 256 + wr * 64 + fr, cb = u.pn * 256 + wc * 32 + 8 * fq;
        FOR_AI_M { const int row = rowb + ai * 128 + m * 16; const size_t o = (size_t)row * 1024 + cb; float s = 0.f;
            FOR_BJ { const f32x4 x0 = *(const f32x4*)(X + o + bj * 128) + acc[ai][bj][m][0], x1 = *(const f32x4*)(X + o + bj * 128 + 4) + acc[ai][bj][m][1];
                *(f32x4*)(X + o + bj * 128) = x0; *(f32x4*)(X + o + bj * 128 + 4) = x1;
                s += (x0[0] * x0[0] + x0[1] * x0[1]) + (x0[2] * x0[2] + x0[3] * x0[3]) + (x1[0] * x1[0] + x1[1] * x1[1]) + (x1[2] * x1[2] + x1[3] * x1[3]); }
            s += __shfl_xor(s, 16); s += __shfl_xor(s, 32);
            if (fq == 0) SS[(size_t)row * 16 + u.pn * 4 + wc] = s; }
    }
};
__device__ __forceinline__ f32x4 dpp4_shr(f32x4 old, f32x4 src, int which) { f32x4 r;
#pragma unroll
    for (int e = 0; e < 4; ++e) { const int o = __float_as_int(old[e]), s = __float_as_int(src[e]);
        r[e] = __int_as_float(which == 1 ? __builtin_amdgcn_update_dpp(o, s, 0x111, 0xf, 0xf, false) : __builtin_amdgcn_update_dpp(o, s, 0x112, 0xf, 0xf, false)); }
    return r; }
__device__ __forceinline__ f32x4 dpp4_ror(f32x4 src, int which) { f32x4 r;
#pragma unroll
    for (int e = 0; e < 4; ++e) { const int s = __float_as_int(src[e]);
        r[e] = __int_as_float(which == 1 ? __builtin_amdgcn_update_dpp(s, s, 0x121, 0xf, 0xf, false) : __builtin_amdgcn_update_dpp(s, s, 0x122, 0xf, 0xf, false)); }
    return r; }
struct EpiUpf { static constexpr bool PERM = true; const float* SS; const float* wcv; const float* bcv; bf16* AF; float* HF; float* HL;
    __device__ __forceinline__ void operator()(EPI_ARGS) const {
        LAS float* rs = (LAS float*)es; LAS float* xch = (LAS float*)(es + 1024);
        const int tid = wid * 64 + lane;
        { const int r = tid >> 1, hf = tid & 1; const f32x4* p = (const f32x4*)(SS + (size_t)(u.pm * 256 + r) * 16 + hf * 8); const f32x4 a = p[0], b = p[1];
          float s = (a[0] + a[1]) + (a[2] + a[3]) + (b[0] + b[1]) + (b[2] + b[3]); s += __shfl_xor(s, 1); if (hf == 0) rs[r] = rsqrtf(s * (1.f / D_MODEL) + EPS); }
        asm volatile("s_waitcnt lgkmcnt(0)" ::: "memory"); __builtin_amdgcn_s_barrier(); asm volatile("" ::: "memory");
        FOR_AI_M { const float r_ = rs[ai * 128 + wr * 64 + m * 16 + fr]; FOR_BJ { acc[ai][bj][m][0] = acc[ai][bj][m][0] * r_; acc[ai][bj][m][1] = acc[ai][bj][m][1] * r_; } }
        const int colb = u.pn * 256 + wc * 32 + 8 * fq;
        if (fr >= 14) {
#pragma unroll
            for (int ai = 0; ai < 2; ++ai) { LAS f32x4* d = (LAS f32x4*)(xch + (size_t)(((((2 * ai + wr) * 4 + wc) * 2 + (fr - 14)) * 4 + fq) * 16));
                d[0] = acc[ai][0][3][0]; d[1] = acc[ai][0][3][1]; d[2] = acc[ai][1][3][0]; d[3] = acc[ai][1][3][1]; }
            if (wr == 1) { float* hp = HL + ((size_t)u.pm * 2 + (fr - 14)) * NUP + colb; FOR_BJ { *(f32x4*)(hp + bj * 128) = acc[1][bj][3][0]; *(f32x4*)(hp + bj * 128 + 4) = acc[1][bj][3][1]; } }
        }
        if (fr < 2 && wr == 0) { float* hp = HF + ((size_t)u.pm * 2 + fr) * NUP + colb; FOR_BJ { *(f32x4*)(hp + bj * 128) = acc[0][bj][0][0]; *(f32x4*)(hp + bj * 128 + 4) = acc[0][bj][0][1]; } }
        asm volatile("s_waitcnt lgkmcnt(0)" ::: "memory"); __builtin_amdgcn_s_barrier(); asm volatile("" ::: "memory");
        const int ffb = u.pn * 128 + wc * 32 + 8 * fq;
#pragma unroll
        for (int n = 0; n < 2; ++n) {
            const int ff = ffb + 4 * n;
            const f32x4 wg0 = *(const f32x4*)(wcv + ff), wg1 = *(const f32x4*)(wcv + NUP + ff), wg2 = *(const f32x4*)(wcv + 2 * NUP + ff), bg = *(const f32x4*)(bcv + ff);
            const f32x4 wv0 = *(const f32x4*)(wcv + DFF + ff), wv1 = *(const f32x4*)(wcv + NUP + DFF + ff), wv2 = *(const f32x4*)(wcv + 2 * NUP + DFF + ff), bv = *(const f32x4*)(bcv + DFF + ff);
#pragma unroll
            for (int ai = 0; ai < 2; ++ai) {
                const int s = 2 * ai + wr;
                f32x4 g1 = {0.f, 0.f, 0.f, 0.f}, g2 = g1, v1 = g1, v2 = g1;
                if (s > 0) { const LAS f32x4* r14 = (const LAS f32x4*)(xch + (size_t)(((((s - 1) * 4 + wc) * 2 + 0) * 4 + fq) * 16)); const LAS f32x4* r15 = r14 + 16;
                    g1 = r15[n]; v1 = r15[2 + n]; g2 = fr == 0 ? r14[n] : r15[n]; v2 = fr == 0 ? r14[2 + n] : r15[2 + n]; }
#pragma unroll
                for (int m = 0; m < 4; ++m) {
                    const f32x4 cg = acc[ai][0][m][n], cv = acc[ai][1][m][n];
                    if (m > 0) { g1 = dpp4_ror(acc[ai][0][m - 1][n], 1); g2 = dpp4_ror(acc[ai][0][m - 1][n], 2); v1 = dpp4_ror(acc[ai][1][m - 1][n], 1); v2 = dpp4_ror(acc[ai][1][m - 1][n], 2); }
                    const f32x4 pg1 = dpp4_shr(g1, cg, 1), pg2 = dpp4_shr(g2, cg, 2), pv1 = dpp4_shr(v1, cv, 1), pv2 = dpp4_shr(v2, cv, 2);
                    const f32x4 hg = bg + wg0 * pg2 + wg1 * pg1 + wg2 * cg, hv = bv + wv0 * pv2 + wv1 * pv1 + wv2 * cv;
                    f32x4 o; _Pragma("unroll") for (int e = 0; e < 4; ++e) o[e] = hg[e] * fsig(hg[e]) * hv[e];
                    u32x2 w; w.x = cvt_pk_bf16(o[0], o[1]); w.y = cvt_pk_bf16(o[2], o[3]);
                    *(u32x2*)(AF + (size_t)(u.pm * 256 + ai * 128 + wr * 64 + m * 16 + fr) * DFF + ff) = w;
                }
            }
        }
    }
};
typedef GAS unsigned gu32;
#define RLX_AGENT __ATOMIC_RELAXED, __HIP_MEMORY_SCOPE_AGENT
#define XB_TMO      128
#define XB_XCNT(j)  (256  + 64 * (j))
#define XB_XSUB(j)  (1280 + 64 * (j))
#define XB_XGEN(j)  (2304 + 64 * (j))
#define XB_TOP      3328
#define XB_TOPGEN   3392
#define XCD_BAR_WORDS 3456
#define XB_SPIN_CAP (1u << 18)
__device__ __forceinline__ unsigned xb_ld(unsigned* p)              { return __hip_atomic_load(p, __ATOMIC_RELAXED, __HIP_MEMORY_SCOPE_AGENT); }
__device__ __forceinline__ unsigned xb_add(unsigned* p, unsigned v) { return __hip_atomic_fetch_add(p, v, __ATOMIC_RELAXED, __HIP_MEMORY_SCOPE_AGENT); }
__device__ __forceinline__ unsigned xb_xcc_id() { return (unsigned)__builtin_amdgcn_s_getreg((3 << 11) | 20) & 0xFu; }
#define XB_SPIN(cond, bar) do { unsigned _sp = 0; while (cond) { __builtin_amdgcn_s_sleep(1); \
    if ((++_sp & 255u) == 0u) { if (xb_ld(&(bar)[XB_TMO])) break; if (_sp > XB_SPIN_CAP) { atomicAdd(&(bar)[XB_TMO], 1u); break; } } } } while (0)
struct XcdBarrier { unsigned* bar; unsigned x; volatile LAS unsigned* st; };
__device__ __forceinline__ XcdBarrier xcd_barrier_post(unsigned* bar, volatile LAS unsigned* st) {
    XcdBarrier b; b.bar = bar; b.x = xb_xcc_id(); b.st = st;
    if (threadIdx.x == 0) (void)xb_add(&bar[XB_XCNT(b.x)], 1u);
    return b;
}
__device__ __forceinline__ void xcd_barrier_complete(unsigned* bar, unsigned x, unsigned& nloc, unsigned& nx) {
    const unsigned G = gridDim.x * gridDim.y * gridDim.z;
    unsigned sum, cnt, mine, sp = 0u;
    for (;;) {
        sum = 0u; cnt = 0u; mine = 0u;
#pragma unroll
        for (unsigned j = 0; j < 16; ++j) { const unsigned c = xb_ld(&bar[XB_XCNT(j)]); sum += c; cnt += (c > 0u) ? 1u : 0u; mine = (j == x) ? c : mine; }
        if (sum == G) break;
        __builtin_amdgcn_s_sleep(1);
        if ((++sp & 255u) == 0u) { if (xb_ld(&bar[XB_TMO])) break; if (sp > XB_SPIN_CAP) { atomicAdd(&bar[XB_TMO], 1u); break; } }
    }
    nloc = mine > 0u ? mine : 1u; nx = cnt > 0u ? cnt : 1u;
}
__device__ __forceinline__ void xcd_barrier(const XcdBarrier& b) {
    asm volatile("s_waitcnt vmcnt(0)" ::: "memory");
    __syncthreads();
    if (threadIdx.x == 0) {
        unsigned* bar = b.bar;
        __builtin_amdgcn_s_waitcnt(0);
        unsigned nloc = b.st[0], nx = b.st[1];
        if (nloc == 0u) { xcd_barrier_complete(bar, b.x, nloc, nx); b.st[0] = nloc; b.st[1] = nx; }
        const unsigned old = xb_add(&bar[XB_XSUB(b.x)], 1u);
        const unsigned gen = old / nloc;
        if (old + 1u == (gen + 1u) * nloc) {
            __builtin_amdgcn_fence(__ATOMIC_RELEASE, "agent");
            asm volatile("s_waitcnt vmcnt(0)" ::: "memory");
            const unsigned og = xb_add(&bar[XB_TOP], 1u);
            const unsigned tg = og / nx;
            if (og + 1u == (tg + 1u) * nx) xb_add(&bar[XB_TOPGEN], 1u);
            else XB_SPIN(xb_ld(&bar[XB_TOPGEN]) == tg, bar);
            __builtin_amdgcn_fence(__ATOMIC_ACQUIRE, "agent");
            xb_add(&bar[XB_XGEN(b.x)], 1u);
            asm volatile("s_waitcnt vmcnt(0)" ::: "memory");
        } else {
            XB_SPIN(xb_ld(&bar[XB_XGEN(b.x)]) == gen, bar);
            __builtin_amdgcn_fence(__ATOMIC_ACQUIRE, "agent");
            asm volatile("s_waitcnt vmcnt(0)" ::: "memory");
        }
    }
    __syncthreads();
}

#define LDS_WAIT() asm volatile("s_waitcnt lgkmcnt(0)" ::: "memory")
__device__ __forceinline__ unsigned pk2(float lo, float hi) { return (unsigned)f2bf(lo) | ((unsigned)f2bf(hi) << 16); }
__device__ __forceinline__ void p0_transpose_item(const float* W, int K, int N, bf16* WT, int k0, int n0, int drow0, LAS float* scr, int lane) {
#pragma unroll 8
    for (int i = 0; i < 32; ++i) { const int kk = 2 * i + (lane >> 5); scr[kk * 33 + (lane & 31)] = W[(size_t)(k0 + kk) * N + n0 + (lane & 31)]; }
    LDS_WAIT(); asm volatile("" ::: "memory");
    const int c = lane & 7;
#pragma unroll
    for (int j = 0; j < 4; ++j) { const int n = (lane >> 3) + 8 * j; const LAS float* s = scr + (8 * c) * 33 + n;
        u32x4 o; o.x = pk2(s[0 * 33], s[1 * 33]); o.y = pk2(s[2 * 33], s[3 * 33]); o.z = pk2(s[4 * 33], s[5 * 33]); o.w = pk2(s[6 * 33], s[7 * 33]);
        *(u32x4*)(WT + (size_t)(drow0 + n) * K + k0 + 8 * c) = o; }
    LDS_WAIT(); asm volatile("" ::: "memory");
}

struct Args { const float* in[24]; float* out; unsigned char* ws; int ph_lo, ph_hi; };

struct Ptrs {
    bf16 *Win, *Wglu, *Wpa, *Wpb, *Wout, *Wup, *Wdn;
    bf16 *XN, *Zq, *Zi, *Zg, *UA, *Ga, *Gb, *YA, *YB, *YA2, *T, *Mm, *XG, *AF;
    float *LB, *LF, *SS1, *SS2, *HF, *HL;
};


struct PtrsLazy { unsigned char* ws; unsigned char* dob;
#define PL(name, type, base, off) __device__ __forceinline__ type* name() const { return (type*)(base + (off)); }
    PL(Win_, bf16, ws, WS_W_IN) PL(Wglu_, bf16, ws, WS_W_GLU) PL(Wpa_, bf16, ws, WS_W_PA) PL(Wpb_, bf16, ws, WS_W_PB) PL(Wout_, bf16, ws, WS_W_OUT) PL(Wup_, bf16, ws, WS_W_UP) PL(Wdn_, bf16, ws, WS_W_DN)
    PL(XN_, bf16, ws, WS_XN) PL(Zq_, bf16, ws, WS_ZQ) PL(Zi_, bf16, ws, WS_ZI) PL(Zg_, bf16, ws, WS_ZG) PL(UA_, bf16, ws, WS_UA) PL(Ga_, bf16, ws, WS_GA) PL(Gb_, bf16, ws, WS_GB)
    PL(YA_, bf16, dob, DO_YA) PL(YB_, bf16, dob, DO_YB) PL(YA2_, bf16, dob, DO_YA2) PL(T_, bf16, ws, WS_T) PL(Mm_, bf16, ws, WS_MM) PL(XG_, bf16, ws, WS_XG) PL(AF_, bf16, ws, WS_AF)
    PL(LB_, float, ws, WS_SMALL) PL(LF_, float, ws, WS_LF) PL(SS1_, float, ws, WS_SS1) PL(SS2_, float, ws, WS_SS2) PL(HF_, float, ws, WS_HF) PL(HL_, float, ws, WS_HL)
#undef PL
};
__device__ __forceinline__ void phase_prologue(const Args& a, const PtrsLazy& P, LAS unsigned char* lds, int vcu, int G, int wave, int lane) {
    LAS float* scr = (LAS float*)(lds + wave * 16384);
    const int gw = vcu * NWAVES + wave, NGW = G * NWAVES;
    constexpr int I_IN = 16 * (NIN / 32), I_GLU = 8 * 16, I_PA = 8 * 32, I_PB = 8 * 32, I_OUT = 16 * 32, I_UP = 16 * (NUP / 32), I_DN = (DFF / 64) * 32;
    constexpr int NITEMS = I_IN + I_GLU + I_PA + I_PB + I_OUT + I_UP + I_DN;
    for (int it = gw; it < NITEMS; it += NGW) {
        int r = it;
        if (r < I_IN) { const int nb = r % (NIN / 32), kb = r / (NIN / 32); p0_transpose_item(a.in[2], 1024, NIN, P.Win_(), kb * 64, nb * 32, nb * 32, scr, lane); continue; } r -= I_IN;
        if (r < I_GLU) { const int nb = r % 16, kb = r / 16; p0_transpose_item(a.in[11], 512, 512, P.Wglu_(), kb * 64, nb * 32, nb * 32, scr, lane); continue; } r -= I_GLU;
        if (r < I_PA) { const int nb = r % 32, kb = r / 32; p0_transpose_item(a.in[15], 512, 1024, P.Wpa_(), kb * 64, nb * 32, nb * 32, scr, lane); continue; } r -= I_PA;
        if (r < I_PB) { const int nb = r % 32, kb = r / 32; p0_transpose_item(a.in[16], 512, 1024, P.Wpb_(), kb * 64, nb * 32, nb * 32, scr, lane); continue; } r -= I_PB;
        if (r < I_OUT) { const int nb = r % 32, kb = r / 32; p0_transpose_item(a.in[17], 1024, 1024, P.Wout_(), kb * 64, nb * 32, nb * 32, scr, lane); continue; } r -= I_OUT;
        if (r < I_UP) { const int nb = r % (NUP / 32), kb = r / (NUP / 32); const int n0 = nb * 32; const int isv = n0 >= DFF ? 1 : 0, ff = n0 - isv * DFF;
            p0_transpose_item(a.in[19], 1024, NUP, P.Wup_(), kb * 64, n0, (ff >> 7) * 256 + isv * 128 + (ff & 127), scr, lane); continue; } r -= I_UP;
        { const int nb = r % 32, kb = r / 32; p0_transpose_item(a.in[22], DFF, 1024, P.Wdn_(), kb * 64, nb * 32, nb * 32, scr, lane); }
    }
    const float* gm = a.in[1];
    for (int row = gw; row < M; row += NGW) {
        const f32x4* xr = (const f32x4*)(a.in[0] + (size_t)row * D_MODEL) + lane;
        f32x4 v[4]; float s = 0.f;
#pragma unroll
        for (int j = 0; j < 4; ++j) { v[j] = xr[64 * j]; s += (v[j][0] * v[j][0] + v[j][1] * v[j][1]) + (v[j][2] * v[j][2] + v[j][3] * v[j][3]); }
#pragma unroll
        for (int o_ = 1; o_ < 64; o_ <<= 1) s += __shfl_xor(s, o_);
        const float rstd = rsqrtf(s * (1.f / D_MODEL) + EPS);
        u32x2* o8 = (u32x2*)(P.XN_() + (size_t)row * D_MODEL) + lane;
#pragma unroll
        for (int j = 0; j < 4; ++j) { const f32x4 gv = *((const f32x4*)gm + lane + 64 * j); u32x2 w; w.x = cvt_pk_bf16(v[j][0] * rstd * gv[0], v[j][1] * rstd * gv[1]); w.y = cvt_pk_bf16(v[j][2] * rstd * gv[2], v[j][3] * rstd * gv[3]); o8[64 * j] = w; }
    }
    if (vcu == 0) { const int c = wave * 64 + lane; const float l0 = a.in[13][c], l1 = a.in[13][HGW + c]; P.LB_()[c] = 1.f / (1.f + expf(l1 - l0)); }
}

__device__ __forceinline__ void phase_fixup(const Args& a, const PtrsLazy& P, int vcu, int G, int tid) {
    const float* wcv = a.in[20]; const float* bcv = a.in[21];
    const int total = 128 * 2 * DFF;
    for (int e = vcu * 512 + tid; e < total; e += G * 512) {
        const int ff = e % DFF, r = (e / DFF) & 1, pm = e / (2 * DFF);
        if ((pm & 7) == 0) continue;
        const int cg = (ff >> 7) * 256 + (ff & 127), cv = cg + 128;
        const float* hl = P.HL_() + (size_t)(pm - 1) * 2 * NUP; const float* hf = P.HF_() + (size_t)pm * 2 * NUP;
        float g2, g1, g0, v2, v1, v0;
        if (r == 0) { g2 = hl[cg]; g1 = hl[NUP + cg]; g0 = hf[cg]; v2 = hl[cv]; v1 = hl[NUP + cv]; v0 = hf[cv]; }
        else { g2 = hl[NUP + cg]; g1 = hf[cg]; g0 = hf[NUP + cg]; v2 = hl[NUP + cv]; v1 = hf[cv]; v0 = hf[NUP + cv]; }
        const float hg = bcv[ff] + wcv[ff] * g2 + wcv[NUP + ff] * g1 + wcv[2 * NUP + ff] * g0;
        const float hv = bcv[DFF + ff] + wcv[DFF + ff] * v2 + wcv[NUP + DFF + ff] * v1 + wcv[2 * NUP + DFF + ff] * v0;
        P.AF_()[(size_t)(pm * 256 + r) * DFF + ff] = f2bf(hg * fsig(hg) * hv);
    }
}
__device__ __forceinline__ void phase_final(const Args& a, const PtrsLazy& P, int vcu, int G, int wave, int lane) {
    const int gw = vcu * NWAVES + wave, NGW = G * NWAVES; const float* gf = a.in[23];
    for (int row = gw; row < M; row += NGW) {
        float s = lane < 16 ? P.SS2_()[(size_t)row * 16 + lane] : 0.f;
#pragma unroll
        for (int o_ = 1; o_ < 16; o_ <<= 1) s += __shfl_xor(s, o_);
        s = __shfl(s, 0);
        const float rstd = rsqrtf(s * (1.f / D_MODEL) + EPS);
        f32x4* xr = (f32x4*)(a.out + (size_t)row * D_MODEL) + lane;
#pragma unroll
        for (int j = 0; j < 4; ++j) { const f32x4 gv = *((const f32x4*)gf + lane + 64 * j); xr[64 * j] = xr[64 * j] * rstd * gv; }
    }
}
constexpr size_t DO_SX = 96 * MiB;
__device__ __forceinline__ f32x4 mfma16(bf16x8 a, bf16x8 b, f32x4 c) { return __builtin_amdgcn_mfma_f32_16x16x32_bf16(a, b, c, 0, 0, 0); }
#define BLK_SYNC() do { asm volatile("s_waitcnt lgkmcnt(0)" ::: "memory"); __builtin_amdgcn_s_barrier(); asm volatile("" ::: "memory"); } while (0)

__device__ __forceinline__ void s5_tables_item(const Args& a, bf16* BT, bf16* PM, LAS unsigned char* lds, int g, int h, int tid) {
    LAS f32x2* lt = (LAS f32x2*)lds;
    LAS f32x2* bbs = (LAS f32x2*)(lds + 33280);
    LAS f32x2* cw = (LAS f32x2*)(lds + 33280 + 8192);
    LAS bf16* KcL = (LAS bf16*)(lds + 33280 + 8192 + 512);
    if (tid < 64) {
        const int p = tid;
        const double dt = exp((double)a.in[5][g]);
        const double ar = a.in[3][g * 64 + p], ai = a.in[4][g * 64 + p];
        const double mag = exp(ar * dt), ang = ai * dt;
        const double lr = mag * cos(ang), li = mag * sin(ang);
        const double den = ar * ar + ai * ai, nr = lr - 1.0, ni = li;
        const double cor = (nr * ar + ni * ai) / den, coi = (ni * ar - nr * ai) / den;
        for (int hh = 0; hh < 16; ++hh) { const double br = a.in[6][(g * 64 + p) * 16 + hh], bi = a.in[7][(g * 64 + p) * 16 + hh];
            bbs[p * 16 + hh] = (f32x2){(float)(cor * br - coi * bi), (float)(cor * bi + coi * br)}; }
        cw[p] = (f32x2){a.in[8][(g * 16 + h) * 64 + p], a.in[9][(g * 16 + h) * 64 + p]};
        double xr = 1.0, xi = 0.0;
        for (int tau = 0; tau <= 64; ++tau) { lt[tau * 64 + p] = (f32x2){(float)xr, (float)xi}; const double t2 = xr * lr - xi * li; xi = xr * li + xi * lr; xr = t2; }
    }
    for (int e = tid; e < 64 * 16; e += 512) KcL[e] = 0;
    BLK_SYNC();
#pragma unroll
    for (int e = 0; e < 2; ++e) { const int idx = tid * 2 + e, tau = idx >> 4, hp = idx & 15; float s = 0.f;
        for (int p = 0; p < 64; ++p) { const f32x2 c = cw[p], l = lt[tau * 64 + p], b = bbs[p * 16 + hp];
            const float wr_ = c.x * l.x - c.y * l.y, wi_ = c.x * l.y + c.y * l.x; s += wr_ * b.x - wi_ * b.y; }
        KcL[(64 + tau) * 16 + hp] = f2bf(s); }
    BLK_SYNC();
    for (int e = tid; e < 64 * 144; e += 512) { const int t = e / 144, pc = e % 144;
        bf16* dst = BT + ((size_t)(g * 1024 + t * 16 + h)) * UAK + pc * 8;
        u32x4 w;
        if (pc < 128) { const int s = pc >> 1, half = pc & 1; w = *(const LAS u32x4*)(KcL + (t - s + 64) * 16 + half * 8); }
        else { const int p0 = (pc - 128) * 8; float v[8];
#pragma unroll
            for (int q = 0; q < 8; ++q) { const int pp = p0 + q, p = pp & 63; const f32x2 c = cw[p], l = lt[(t + 1) * 64 + p];
                v[q] = pp < 64 ? (c.x * l.x - c.y * l.y) : -(c.x * l.y + c.y * l.x); }
            w.x = cvt_pk_bf16(v[0], v[1]); w.y = cvt_pk_bf16(v[2], v[3]); w.z = cvt_pk_bf16(v[4], v[5]); w.w = cvt_pk_bf16(v[6], v[7]); }
        *(u32x4*)dst = w; }
    for (int e = tid; e < 8 * 128; e += 512) { const int rr = e >> 7, pc = e & 127, pp = 8 * h + rr, p = pp & 63, s = pc >> 1, half = pc & 1;
        const f32x2 l = lt[(63 - s) * 64 + p]; float v[8];
#pragma unroll
        for (int q = 0; q < 8; ++q) { const f32x2 b = bbs[p * 16 + half * 8 + q]; v[q] = pp < 64 ? (l.x * b.x - l.y * b.y) : (l.x * b.y + l.y * b.x); }
        u32x4 w; w.x = cvt_pk_bf16(v[0], v[1]); w.y = cvt_pk_bf16(v[2], v[3]); w.z = cvt_pk_bf16(v[4], v[5]); w.w = cvt_pk_bf16(v[6], v[7]);
        *(u32x4*)(PM + ((size_t)(g * 128 + pp)) * 1024 + s * 16 + half * 8) = w; }
    BLK_SYNC();
}

struct S5Order { int c, G; __device__ bool next(int i, Unit& o) const { const int L = i * G + c; if (L >= 256) return false; o.pz = L >> 3; o.pm = (L >> 2) & 1; o.pn = L & 3; return true; } };
struct OneUnit { Unit u; __device__ bool next(int i, Unit& o) const { if (i > 0) return false; o = u; return true; } };
struct EpiS5sum { static constexpr bool PERM = true; float* Sx;
    __device__ __forceinline__ void operator()(EPI_ARGS) const {
        const int rowb = u.pm * 256 + wr * 64 + fr, cb = wc * 32 + 8 * fq;
        FOR_AI_M { float* rp = Sx + ((size_t)u.pz * 512 + rowb + ai * 128 + m * 16) * 128 + cb; *(f32x4*)rp = acc[ai][0][m][0]; *(f32x4*)(rp + 4) = acc[ai][0][m][1]; }
    }
};
struct EpiS5main { static constexpr bool PERM = true; const bf16* UA; const float* dsk; bf16* YA;
    __device__ __forceinline__ void operator()(EPI_ARGS) const {
        const int g = u.pz, rowb = u.pm * 256 + wr * 64 + fr;
        FOR_BJ { const int n0 = u.pn * 256 + bj * 128 + wc * 32 + 8 * fq, t = n0 >> 4, h0 = n0 & 15;
            const f32x4 d0 = *(const f32x4*)(dsk + g * 16 + h0), d1 = *(const f32x4*)(dsk + g * 16 + h0 + 4);
            FOR_AI_M { const int r = rowb + ai * 128 + m * 16, b = r >> 5, c = r & 31;
                f32x4 u0, u1; unpack8(*(const u32x4*)(UA + ((size_t)g * 512 + r) * UAK + n0), u0, u1);
                f32x4 y0 = acc[ai][bj][m][0] + d0 * u0, y1 = acc[ai][bj][m][1] + d1 * u1;
                _Pragma("unroll") for (int e = 0; e < 4; ++e) { y0[e] = fgelu(y0[e]); y1[e] = fgelu(y1[e]); }
                *(u32x4*)(YA + ((size_t)(b * SEQ + c * 64 + t)) * 512 + g * 16 + h0) = pack8(y0, y1); } }
    }
};

__device__ __forceinline__ void s5_scan(const Args& a, const float* Sx, bf16* UA, int gt) {
    const int p = gt & 63, g = (gt >> 6) & 31, b = gt >> 11;
    const double dt = exp((double)a.in[5][g]) * 64.0;
    const double mag = exp((double)a.in[3][g * 64 + p] * dt), ang = (double)a.in[4][g * 64 + p] * dt;
    const float lr = (float)(mag * cos(ang)), li = (float)(mag * sin(ang));
    const float* sp = Sx + ((size_t)g * 512 + b * 32) * 128 + p;
    bf16* up = UA + ((size_t)g * 512 + b * 32) * UAK + 1024 + p;
    float sr[32], si[32];
#pragma unroll
    for (int c = 0; c < 32; ++c) { sr[c] = sp[c * 128]; si[c] = sp[c * 128 + 64]; }
    float xr = 0.f, xi = 0.f;
#pragma unroll
    for (int c = 0; c < 32; ++c) { up[(size_t)c * UAK] = f2bf(xr); up[(size_t)c * UAK + 64] = f2bf(xi);
        const float nr = lr * xr - li * xi + sr[c], ni = lr * xi + li * xr + si[c]; xr = nr; xi = ni; }
}

constexpr int HL_TOT = 0, HL_QT = 2048, HL_KK = HL_QT + 64 * 272, HL_IT = HL_KK + 64 * 272, HL_PT = HL_IT + 128 * 144, HL_KT = HL_PT + 64 * 144, HL_OL = HL_KT + 128 * 144, HL_SSQ = HL_OL + 64 * 128 * 4, HL_END = HL_SSQ + 8 * 64 * 4;
static_assert(HL_END <= RING_BYTES, "hgrn lds");
__device__ __forceinline__ void hg_scan(const float* LFt, LAS unsigned char* lds, int tid, float (&lf)[16], float (&bc)[16], float& blast) {
    const int k = tid & 127, seg = tid >> 7; LAS float* tot = (LAS float*)(lds + HL_TOT);
    const float* p = LFt + (size_t)(seg * 16) * 512 + k;
#pragma unroll
    for (int j = 0; j < 16; ++j) lf[j] = p[(size_t)j * 512];
    float run = 0.f;
#pragma unroll
    for (int j = 0; j < 16; ++j) { run += lf[j]; bc[j] = run; }
    tot[seg * 128 + k] = run;
    BLK_SYNC();
    const float t0 = tot[k], t1 = tot[128 + k], t2 = tot[256 + k], t3 = tot[384 + k];
    const float off = seg == 0 ? 0.f : seg == 1 ? t0 : seg == 2 ? t0 + t1 : (t0 + t1) + t2;
    blast = ((t0 + t1) + t2) + t3;
#pragma unroll
    for (int j = 0; j < 16; ++j) bc[j] += off;
}
__device__ __forceinline__ void hg_stage_it(const bf16* Zit, LAS unsigned char* lds, int tid) {
    const int v = tid & 127, seg = tid >> 7; const bf16* p = Zit + (size_t)(seg * 16) * 512 + v;
    unsigned short x[16];
#pragma unroll
    for (int j = 0; j < 16; ++j) x[j] = p[(size_t)j * 512];
    u32x4 w0, w1; w0.x = x[0] | ((unsigned)x[1] << 16); w0.y = x[2] | ((unsigned)x[3] << 16); w0.z = x[4] | ((unsigned)x[5] << 16); w0.w = x[6] | ((unsigned)x[7] << 16);
    w1.x = x[8] | ((unsigned)x[9] << 16); w1.y = x[10] | ((unsigned)x[11] << 16); w1.z = x[12] | ((unsigned)x[13] << 16); w1.w = x[14] | ((unsigned)x[15] << 16);
    LAS u32x4* d = (LAS u32x4*)(lds + HL_IT + v * 144 + seg * 32); d[0] = w0; d[1] = w1;
}
__device__ __forceinline__ void hg_h1_unit(const float* LF, const bf16* Zi, bf16* DS, float* DEC, LAS unsigned char* lds, int unit, int tid, int wave, int lane) {
    const int bh = unit >> 5, c = unit & 31, b = bh >> 2, h = bh & 3;
    const size_t row0 = (size_t)b * SEQ + c * 64;
    float lf[16], bc[16], blast;
    hg_stage_it(Zi + row0 * 512 + h * 128, lds, tid);
    hg_scan(LF + row0 * 512 + h * 128, lds, tid, lf, bc, blast);
    { const int k = tid & 127, seg = tid >> 7; float v[16];
#pragma unroll
      for (int j = 0; j < 16; ++j) v[j] = (1.f - __expf(lf[j])) * __expf(blast - bc[j]);
      u32x4 w0, w1; w0.x = cvt_pk_bf16(v[0], v[1]); w0.y = cvt_pk_bf16(v[2], v[3]); w0.z = cvt_pk_bf16(v[4], v[5]); w0.w = cvt_pk_bf16(v[6], v[7]);
      w1.x = cvt_pk_bf16(v[8], v[9]); w1.y = cvt_pk_bf16(v[10], v[11]); w1.z = cvt_pk_bf16(v[12], v[13]); w1.w = cvt_pk_bf16(v[14], v[15]);
      LAS u32x4* d = (LAS u32x4*)(lds + HL_KT + k * 144 + seg * 32); d[0] = w0; d[1] = w1;
      if (seg == 0) DEC[(size_t)unit * 128 + k] = __expf(blast); }
    BLK_SYNC();
    const int r = lane & 15, q = lane >> 4;
    bf16x8 af[2];
#pragma unroll
    for (int ks = 0; ks < 2; ++ks) af[ks] = *(const LAS bf16x8*)(lds + HL_KT + (16 * wave + r) * 144 + (ks * 32 + 8 * q) * 2);
    bf16* dst = DS + (size_t)unit * 16384;
#pragma unroll
    for (int vt = 0; vt < 8; ++vt) { f32x4 acc = {0.f, 0.f, 0.f, 0.f};
#pragma unroll
        for (int ks = 0; ks < 2; ++ks) { const bf16x8 bfr = *(const LAS bf16x8*)(lds + HL_IT + (16 * vt + r) * 144 + (ks * 32 + 8 * q) * 2); acc = mfma16(af[ks], bfr, acc); }
        u32x2 w; w.x = cvt_pk_bf16(acc[0], acc[1]); w.y = cvt_pk_bf16(acc[2], acc[3]);
        *(u32x2*)(dst + (size_t)(16 * vt + r) * 128 + 16 * wave + 4 * q) = w; }
    BLK_SYNC();
}
__device__ __forceinline__ void hg_h2(bf16* DS, const float* DEC, int gid) {
    const int kg = gid & 15, v = (gid >> 4) & 127, bh = gid >> 11;
    bf16* p = DS + ((size_t)bh * 32 * 128 + v) * 128 + kg * 8; const float* dp = DEC + (size_t)bh * 32 * 128 + kg * 8;
    f32x4 s0 = {0.f, 0.f, 0.f, 0.f}, s1 = s0;
#pragma unroll 8
    for (int c = 0; c < 32; ++c) { u32x4* pc = (u32x4*)(p + (size_t)c * 16384); f32x4 d0, d1; unpack8(*pc, d0, d1);
        const f32x4 e0 = *(const f32x4*)(dp + c * 128), e1 = *(const f32x4*)(dp + c * 128 + 4);
        *pc = pack8(s0, s1); s0 = e0 * s0 + d0; s1 = e1 * s1 + d1; }
}
__device__ __forceinline__ void hg_h3_unit(const Args& a, const float* LF, const bf16* Zq, const bf16* Zi, const bf16* Zg, const bf16* DS, bf16* YB, LAS unsigned char* lds, int unit, int tid, int wave, int lane) {
    const int bh = unit >> 5, c = unit & 31, b = bh >> 2, h = bh & 3;
    const size_t row0 = (size_t)b * SEQ + c * 64;
    const int r = lane & 15, q = lane >> 4;
    bf16x8 sf[4];
    { const bf16* sp = DS + (size_t)unit * 16384 + (size_t)(16 * wave + r) * 128 + 8 * q;
#pragma unroll
      for (int ks = 0; ks < 4; ++ks) sf[ks] = *(const bf16x8*)(sp + ks * 32); }
    float lf[16], bc[16], blast;
    hg_stage_it(Zi + row0 * 512 + h * 128, lds, tid);
    { const int k = tid & 127, seg = tid >> 7; const bf16* qp = Zq + (row0 + seg * 16) * 512 + h * 128 + k; unsigned short qv[16];
#pragma unroll
      for (int j = 0; j < 16; ++j) qv[j] = qp[(size_t)j * 512];
      hg_scan(LF + row0 * 512 + h * 128, lds, tid, lf, bc, blast);
      LAS bf16* qt = (LAS bf16*)(lds + HL_QT) + (seg * 16) * 136 + k; LAS bf16* kk = (LAS bf16*)(lds + HL_KK) + (seg * 16) * 136 + k;
#pragma unroll
      for (int j = 0; j < 16; ++j) { const float eb = __expf(bc[j]); qt[j * 136] = f2bf(bf2f(qv[j]) * eb); kk[j * 136] = f2bf((1.f - __expf(lf[j])) * __builtin_amdgcn_rcpf(eb)); } }
    BLK_SYNC();
    { const int tt = wave >> 1;
#pragma unroll
      for (int e = 0; e < 2; ++e) { const int st = (wave & 1) * 2 + e; f32x4 acc = {0.f, 0.f, 0.f, 0.f};
        if (st <= tt) {
#pragma unroll
            for (int ks = 0; ks < 4; ++ks) { const bf16x8 af = *(const LAS bf16x8*)(lds + HL_QT + (16 * tt + r) * 272 + (ks * 32 + 8 * q) * 2), bfr = *(const LAS bf16x8*)(lds + HL_KK + (16 * st + r) * 272 + (ks * 32 + 8 * q) * 2); acc = mfma16(af, bfr, acc); }
        }
        LAS bf16* pt = (LAS bf16*)(lds + HL_PT) + (16 * tt + 4 * q) * 72 + 16 * st + r;
#pragma unroll
        for (int g_ = 0; g_ < 4; ++g_) { const int t = 16 * tt + 4 * q + g_, s = 16 * st + r; pt[g_ * 72] = (st <= tt && s <= t) ? f2bf(acc[g_]) : (bf16)0; } } }
    BLK_SYNC();
    f32x4 o[4];
#pragma unroll
    for (int tt = 0; tt < 4; ++tt) { o[tt] = (f32x4){0.f, 0.f, 0.f, 0.f};
#pragma unroll
        for (int ks = 0; ks < 4; ++ks) { const bf16x8 af = *(const LAS bf16x8*)(lds + HL_QT + (16 * tt + r) * 272 + (ks * 32 + 8 * q) * 2); o[tt] = mfma16(af, sf[ks], o[tt]); }
#pragma unroll
        for (int ks = 0; ks < 2; ++ks) { const bf16x8 af = *(const LAS bf16x8*)(lds + HL_PT + (16 * tt + r) * 144 + (ks * 32 + 8 * q) * 2), bfr = *(const LAS bf16x8*)(lds + HL_IT + (16 * wave + r) * 144 + (ks * 32 + 8 * q) * 2); o[tt] = mfma16(af, bfr, o[tt]); } }
    { LAS float* ol = (LAS float*)(lds + HL_OL); LAS float* ssq = (LAS float*)(lds + HL_SSQ);
#pragma unroll
      for (int tt = 0; tt < 4; ++tt)
#pragma unroll
        for (int g_ = 0; g_ < 4; ++g_) { const int t = 16 * tt + 4 * q + g_; const float v = o[tt][g_]; ol[t * 128 + 16 * wave + r] = v;
            float s = v * v; s += __shfl_xor(s, 1); s += __shfl_xor(s, 2); s += __shfl_xor(s, 4); s += __shfl_xor(s, 8);
            if (r == 0) ssq[wave * 64 + t] = s; } }
    BLK_SYNC();
    { const int t = tid >> 3, v0 = (tid & 7) * 16; const LAS float* ssq = (const LAS float*)(lds + HL_SSQ); const LAS float* ol = (const LAS float*)(lds + HL_OL) + t * 128 + v0;
      float s = 0.f;
#pragma unroll
      for (int w = 0; w < 8; ++w) s += ssq[w * 64 + t];
      const float rstd = rsqrtf(s * (1.f / 128.f) + EPS);
      const float* gn = a.in[14] + h * 128 + v0; const size_t oidx = (row0 + t) * 512 + h * 128 + v0;
#pragma unroll
      for (int e = 0; e < 2; ++e) { f32x4 g0, g1; unpack8(*(const u32x4*)(Zg + oidx + e * 8), g0, g1);
          const f32x4 x0 = *(const LAS f32x4*)(ol + e * 8), x1 = *(const LAS f32x4*)(ol + e * 8 + 4), n0 = *(const f32x4*)(gn + e * 8), n1 = *(const f32x4*)(gn + e * 8 + 4);
          *(u32x4*)(YB + oidx + e * 8) = pack8(x0 * rstd * n0 * g0, x1 * rstd * n1 * g1); } }
    BLK_SYNC();
}
constexpr int N_PHASES = 12;
__global__ void __launch_bounds__(NWAVES * 64, 2) mk_fwd(Args args) {
    extern __shared__ __attribute__((aligned(16))) unsigned char lds_raw[];
    LAS unsigned char* lds = (LAS unsigned char*)lds_raw;
    LAS unsigned char* es = lds + EPI_OFF;
    const int tid = threadIdx.x, lane = tid & 63, wave = __builtin_amdgcn_readfirstlane(tid >> 6);
    const int G = gridDim.x; const int bx = blockIdx.x; const int vcu = (G % 8 == 0) ? (bx % 8) * (G / 8) + bx / 8 : bx;
    const PtrsLazy P{args.ws, (unsigned char*)args.out};
    const int lo = args.ph_lo, hi = args.ph_hi;
    volatile LAS unsigned* MISC = (volatile LAS unsigned*)(lds + LDS_BYTES - 64);
    if (tid < 16) MISC[tid] = 0u;
    __syncthreads();
    XcdBarrier bar; bar.bar = (unsigned*)(args.ws + WS_CTL); bar.x = 0; bar.st = nullptr;
    if (hi - lo > 1) bar = xcd_barrier_post((unsigned*)(args.ws + WS_CTL), MISC + 8);
#define IN(k) (lo <= (k) && (k) < hi)
#define SEAM(k) do { if (IN(k) && IN((k) + 1)) xcd_barrier(bar); } while (0)

    if (IN(0)) { phase_prologue(args, P, lds, vcu, G, wave, lane); __syncthreads(); for (int it = vcu; it < 512; it += G) s5_tables_item(args, (bf16*)(args.ws + WS_BT), (bf16*)(args.ws + WS_PM), lds, it >> 4, it & 15, tid); SEAM(0); }
    if (IN(1)) {
        pg8::Gemm g = pg8::plain_gemm(P.XN_(), D_MODEL, P.Win_(), D_MODEL); pg8::StaticOrder S; S.init(M, NIN, G, bx);
        EpiP1f E{P.UA_(), P.Zq_(), P.Zi_(), P.Zg_(), P.Ga_(), P.Gb_(), P.LF_(), P.LB_()};
        pg8::gemm_phase(lds, es, g, S, E); SEAM(1);
    }
        float* Sx = (float*)((unsigned char*)args.out + DO_SX); bf16* DS = (bf16*)(args.ws + WS_XN); float* DEC = (float*)(args.ws + WS_DEC);
    if (IN(2)) {
        for (int uu = vcu; uu < 64; uu += G) {
            pg8::Gemm g; g.A = (const char*)P.UA_(); g.B = (const char*)(args.ws + WS_PM); g.lda = UAK * 2; g.ldb = 2048; g.a_pm = 256L * UAK * 2; g.a_pz = 512L * UAK * 2; g.b_pn = 0; g.b_pz = 128L * 1024 * 2;
            g.hsA = 128L * UAK * 2; g.hsB = 0; g.nt = 16;
            OneUnit S{{uu & 1, 0, uu >> 1}}; EpiS5sum E{Sx};
            pg8::gemm_phase(lds, es, g, S, E);
        }
        if (G == 256) { const int u0 = vcu < 64 ? vcu * 5 : 320 + (vcu - 64) * 9, nu = vcu < 64 ? 5 : 9;
            for (int i = 0; i < nu; ++i) hg_h1_unit(P.LF_(), P.Zi_(), DS, DEC, lds, u0 + i, tid, wave, lane); }
        else for (int uu = vcu; uu < 2048; uu += G) hg_h1_unit(P.LF_(), P.Zi_(), DS, DEC, lds, uu, tid, wave, lane);
        SEAM(2);
    }
    if (IN(3)) {
        for (int gt = vcu * 512 + tid; gt < 32768; gt += G * 512) s5_scan(args, Sx, P.UA_(), gt);
        for (int gid = vcu * 512 + tid; gid < 131072; gid += G * 512) hg_h2(DS, DEC, gid);
        SEAM(3);
    }
    if (IN(4)) {
        { pg8::Gemm g; g.A = (const char*)P.UA_(); g.B = (const char*)(args.ws + WS_BT); g.lda = UAK * 2; g.ldb = UAK * 2; g.a_pm = 256L * UAK * 2; g.a_pz = 512L * UAK * 2; g.b_pn = 256L * UAK * 2; g.b_pz = 1024L * UAK * 2;
          g.hsA = 128L * UAK * 2; g.hsB = 128L * UAK * 2; g.nt = UAK / 64;
          S5Order S{vcu, G}; EpiS5main E{P.UA_(), args.in[10], P.YA_()};
          pg8::gemm_phase(lds, es, g, S, E); }
        if (G == 256) { for (int i = 0; i < 8; ++i) hg_h3_unit(args, P.LF_(), P.Zq_(), P.Zi_(), P.Zg_(), DS, P.YB_(), lds, vcu * 8 + i, tid, wave, lane); }
        else for (int uu = vcu; uu < 2048; uu += G) hg_h3_unit(args, P.LF_(), P.Zq_(), P.Zi_(), P.Zg_(), DS, P.YB_(), lds, uu, tid, wave, lane);
        SEAM(4);
    }

    if (IN(5)) {
        { pg8::Gemm g = pg8::plain_gemm(P.YA_(), 512, P.Wglu_(), 512); pg8::StaticOrder S; S.init(M, 512, G, bx); EpiGluf E{P.YA_(), args.in[12], P.YA2_()}; pg8::gemm_phase(lds, es, g, S, E); }
        { pg8::Gemm g = pg8::plain_gemm(P.YB_(), 512, P.Wpb_(), 512); pg8::StaticOrder S; S.init(M, 1024, G, bx); EpiTf E{P.Gb_(), P.T_()}; pg8::gemm_phase(lds, es, g, S, E); }
        SEAM(5);
    }
    if (IN(6)) { pg8::Gemm g = pg8::plain_gemm(P.YA2_(), 512, P.Wpa_(), 512); pg8::StaticOrder S; S.init(M, 1024, G, bx); EpiMf E{P.Ga_(), P.T_(), P.Mm_()}; pg8::gemm_phase(lds, es, g, S, E); SEAM(6); }
    if (IN(7)) { pg8::Gemm g = pg8::plain_gemm(P.Mm_(), 1024, P.Wout_(), 1024); pg8::StaticOrder S; S.init(M, 1024, G, bx); EpiOutf E{args.in[0], args.in[18], args.out, P.XG_(), P.SS1_()}; pg8::gemm_phase(lds, es, g, S, E); SEAM(7); }
    if (IN(8)) { pg8::Gemm g = pg8::plain_gemm(P.XG_(), 1024, P.Wup_(), 1024); pg8::StaticOrder S; S.init(M, NUP, G, bx); EpiUpf E{P.SS1_(), args.in[20], args.in[21], P.AF_(), P.HF_(), P.HL_()}; pg8::gemm_phase(lds, es, g, S, E); SEAM(8); }
    if (IN(9)) { phase_fixup(args, P, vcu, G, tid); SEAM(9); }
    if (IN(10)) { pg8::Gemm g = pg8::plain_gemm(P.AF_(), DFF, P.Wdn_(), DFF); pg8::StaticOrder S; S.init(M, 1024, G, bx); EpiDownf E{args.out, P.SS2_()}; pg8::gemm_phase(lds, es, g, S, E); SEAM(10); }
    if (IN(11)) { phase_final(args, P, vcu, G, wave, lane); }
#undef IN
#undef SEAM
}

static void launch_phases(const Args& base, int lo, int hi, int grid, hipStream_t stream) {
    Args a = base; a.ph_lo = lo; a.ph_hi = hi;
    hipLaunchKernelGGL(mk_fwd, dim3(grid), dim3(NWAVES * 64), LDS_BYTES, stream, a);
}

extern "C" void kernel_launch(void* const* d_in, const int* in_sizes, int n_in, void* d_out, int out_size, void* d_ws, size_t ws_size, hipStream_t stream) {
    static int grid = 0;
    if (grid == 0) {
        if (n_in != 24 || in_sizes[0] != M * D_MODEL || out_size != M * D_MODEL || ws_size < WS_END) { fprintf(stderr, "kernel_launch: unexpected shapes (n_in %d in0 %d out %d ws %zu)\n", n_in, n_in > 0 ? in_sizes[0] : -1, out_size, ws_size); grid = -1; return; }
        int dev = 0, cus = 0, per_cu = 0;
        hipGetDevice(&dev); hipDeviceGetAttribute(&cus, hipDeviceAttributeMultiprocessorCount, dev);
        if (hipFuncSetAttribute((const void*)mk_fwd, hipFuncAttributeMaxDynamicSharedMemorySize, LDS_BYTES) != hipSuccess) { fprintf(stderr, "kernel_launch: hipFuncSetAttribute failed\n"); grid = -1; return; }
        if (hipOccupancyMaxActiveBlocksPerMultiprocessor(&per_cu, (const void*)mk_fwd, NWAVES * 64, LDS_BYTES) != hipSuccess || per_cu < 1) { fprintf(stderr, "kernel_launch: occupancy query says %d\n", per_cu); }
        (void)hipGetLastError();
        grid = cus;
    }
    if (grid < 0) return;
    Args a{};
    for (int i = 0; i < 24; ++i) a.in[i] = (const float*)d_in[i];
    a.out = (float*)d_out; a.ws = (unsigned char*)d_ws;
    hipMemsetAsync((char*)d_ws + WS_CTL, 0, XCD_BAR_WORDS * 4, stream);

    launch_phases(a, 0, N_PHASES, grid, stream);

}
```

```cpp
#include <hip/hip_runtime.h>
#include <cstdio>
#include <cstdint>
#include <cmath>

typedef unsigned short bf16;
typedef float f32x4 __attribute__((ext_vector_type(4)));

constexpr int D_MODEL = 1024, BATCH = 16, SEQ = 2048, M = BATCH * SEQ;
constexpr int S5W = 512, S5G = 16, S5NG = 32, S5P = 64;
constexpr int HGW = 512, HGD = 128, HGH = 4;
constexpr int DFF = 2816, NUP = 2 * DFF;
constexpr int NIN = 4608;
constexpr float EPS = 1e-6f;
constexpr int UAK = 1152;

constexpr size_t MiB = 1u << 20;
constexpr size_t WS_SMALL = 30 * MiB;
constexpr size_t WS_XN = 118 * MiB;
constexpr size_t WS_ZQ = 182 * MiB, WS_LF = 214 * MiB, WS_ZI = 278 * MiB, WS_ZG = 310 * MiB, WS_UA = 342 * MiB, WS_GA = 378 * MiB, WS_GB = 442 * MiB;
constexpr size_t WS_T = 182 * MiB, WS_MM = 246 * MiB;
constexpr size_t WS_XG = 118 * MiB;
constexpr size_t WS_AF = 182 * MiB;
constexpr size_t WS_SS1 = 506 * MiB;
constexpr size_t WS_END = 512 * MiB;
constexpr size_t DO_YA = 0, DO_YB = 32 * MiB, DO_YA2 = 64 * MiB;

__device__ __forceinline__ float bf2f(bf16 v) { return __uint_as_float((unsigned)v << 16); }
__device__ __forceinline__ bf16 f2bf(float f) { unsigned u = __float_as_uint(f); return (bf16)((u + 0x7fffu + ((u >> 16) & 1u)) >> 16); }
__device__ __forceinline__ float sigmoidf_(float x) { return 1.f / (1.f + __expf(-x)); }
__device__ __forceinline__ float siluf_(float x) { return x / (1.f + __expf(-x)); }
__device__ __forceinline__ float gelu_tanh(float x) { const float u = 0.7978845608028654f * (x + 0.044715f * x * x * x); return 0.5f * x * (1.f + tanhf(u)); }

struct Bufs {
    const float* in[24]; float* out; unsigned char* ws;
};

__global__ void n_lb(const float* logits, float* LB) {
    const int c = blockIdx.x * blockDim.x + threadIdx.x;
    if (c < HGW) { const float l0 = logits[c], l1 = logits[HGW + c]; LB[c] = 1.f / (1.f + expf(l1 - l0)); }
}

__global__ __launch_bounds__(256) void n_rmsnorm_bf16(const float* x, const float* g, bf16* o) {
    const int row = blockIdx.x * 4 + (threadIdx.x >> 6), lane = threadIdx.x & 63;
    const float* xr = x + (size_t)row * D_MODEL;
    float v[16]; float s = 0.f;
#pragma unroll
    for (int j = 0; j < 16; ++j) { v[j] = xr[lane + 64 * j]; s += v[j] * v[j]; }
#pragma unroll
    for (int o_ = 1; o_ < 64; o_ <<= 1) s += __shfl_xor(s, o_);
    const float rstd = rsqrtf(s * (1.f / D_MODEL) + EPS);
#pragma unroll
    for (int j = 0; j < 16; ++j) o[(size_t)row * D_MODEL + lane + 64 * j] = f2bf(v[j] * rstd * g[lane + 64 * j]);
}

template <class Epi>
__global__ __launch_bounds__(256) void n_gemm(const bf16* A, int lda, const float* W, int ldw, int K, Epi epi) {
    __shared__ float As[16][68];
    __shared__ float Ws[16][64];
    const int t = threadIdx.x, tx = t & 15, ty = t >> 4;
    const int row0 = blockIdx.y * 64, col0 = blockIdx.x * 64;
    float acc[4][4];
#pragma unroll
    for (int i = 0; i < 4; ++i)
#pragma unroll
        for (int j = 0; j < 4; ++j) acc[i][j] = 0.f;
    for (int k0 = 0; k0 < K; k0 += 16) {
        { const int r = t >> 2, kk = (t & 3) * 4; const bf16* ap = A + (size_t)(row0 + r) * lda + k0 + kk;
#pragma unroll
          for (int q = 0; q < 4; ++q) As[kk + q][r] = bf2f(ap[q]); }
        { const int kk = t >> 4, c = (t & 15) * 4; const f32x4 w = *(const f32x4*)(W + (size_t)(k0 + kk) * ldw + col0 + c);
          Ws[kk][c] = w.x; Ws[kk][c + 1] = w.y; Ws[kk][c + 2] = w.z; Ws[kk][c + 3] = w.w; }
        __syncthreads();
#pragma unroll
        for (int kk = 0; kk < 16; ++kk) {
            float a[4], b[4];
#pragma unroll
            for (int i = 0; i < 4; ++i) a[i] = As[kk][ty * 4 + i];
#pragma unroll
            for (int j = 0; j < 4; ++j) b[j] = Ws[kk][tx * 4 + j];
#pragma unroll
            for (int i = 0; i < 4; ++i)
#pragma unroll
                for (int j = 0; j < 4; ++j) acc[i][j] += a[i] * b[j];
        }
        __syncthreads();
    }
#pragma unroll
    for (int i = 0; i < 4; ++i)
#pragma unroll
        for (int j = 0; j < 4; ++j) epi(row0 + ty * 4 + i, col0 + tx * 4 + j, acc[i][j]);
}

struct EpiP1 {
    bf16 *UA, *Zq, *Zi, *Zg, *Ga, *Gb; float* LF; const float* LB;
    __device__ void operator()(int row, int col, float v) const {
        if (col < 512) { const int g = col >> 4, h = col & 15; UA[((size_t)g * 512 + (row >> 6)) * UAK + (row & 63) * 16 + h] = f2bf(v); }
        else if (col < 1024) { Zq[(size_t)row * 512 + col - 512] = f2bf(siluf_(v) * 0.08838834764831845f); }
        else if (col < 1536) { const int c = col - 1024; const float lb = LB[c]; const float f = lb + (1.f - lb) * sigmoidf_(v); LF[(size_t)row * 512 + c] = logf(f); }
        else if (col < 2048) { Zi[(size_t)row * 512 + col - 1536] = f2bf(v); }
        else if (col < 2560) { Zg[(size_t)row * 512 + col - 2048] = f2bf(siluf_(v)); }
        else if (col < 3584) { Ga[(size_t)row * 1024 + col - 2560] = f2bf(sigmoidf_(v)); }
        else { Gb[(size_t)row * 1024 + col - 3584] = f2bf(sigmoidf_(v)); }
    }
};

__global__ __launch_bounds__(64) void n_s5(const bf16* UA, const float* a_re, const float* a_im, const float* log_dt, const float* b_re, const float* b_im,
                                            const float* c_re, const float* c_im, const float* dsk, bf16* YA) {
    __shared__ float cs[2][16][65];
    __shared__ float xs[2][64];
    const int b = blockIdx.x >> 5, g = blockIdx.x & 31, p = threadIdx.x;
    const double dt = exp((double)log_dt[g]);
    const double ar = a_re[g * 64 + p], ai = a_im[g * 64 + p];
    const double mag = exp(ar * dt), ang = ai * dt;
    const double lr = mag * cos(ang), li = mag * sin(ang);
    const double den = ar * ar + ai * ai, nr = lr - 1.0, ni = li;
    const double cor = (nr * ar + ni * ai) / den, coi = (ni * ar - nr * ai) / den;
    float bbr[16], bbi[16];
#pragma unroll
    for (int h = 0; h < 16; ++h) { const double br = b_re[(g * 64 + p) * 16 + h], bi = b_im[(g * 64 + p) * 16 + h]; bbr[h] = (float)(cor * br - coi * bi); bbi[h] = (float)(cor * bi + coi * br); }
    for (int h = 0; h < 16; ++h) { cs[0][h][p] = c_re[(g * 16 + h) * 64 + p]; cs[1][h][p] = c_im[(g * 16 + h) * 64 + p]; }
    const float lrf = (float)lr, lif = (float)li;
    float xr = 0.f, xi = 0.f;
    const int hh = p & 15, qq = p >> 4;
    const float dh = dsk[g * 16 + hh];
    __syncthreads();
    for (int t = 0; t < SEQ; ++t) {
        const bf16* up = UA + ((size_t)g * 512 + b * 32 + (t >> 6)) * UAK + (t & 63) * 16;
        float u[16];
#pragma unroll
        for (int h = 0; h < 16; ++h) u[h] = bf2f(up[h]);
        float br = 0.f, bi = 0.f;
#pragma unroll
        for (int h = 0; h < 16; ++h) { br += bbr[h] * u[h]; bi += bbi[h] * u[h]; }
        const float nxr = lrf * xr - lif * xi + br, nxi = lrf * xi + lif * xr + bi;
        xr = nxr; xi = nxi;
        xs[0][p] = xr; xs[1][p] = xi;
        __syncthreads();
        float y = 0.f;
#pragma unroll
        for (int q = 0; q < 16; ++q) { const int pp = qq * 16 + q; y += xs[0][pp] * cs[0][hh][pp] - xs[1][pp] * cs[1][hh][pp]; }
        y += __shfl_xor(y, 16); y += __shfl_xor(y, 32);
        if (qq == 0) { y += dh * u[hh]; YA[(size_t)(b * SEQ + t) * 512 + g * 16 + hh] = f2bf(gelu_tanh(y)); }
        __syncthreads();
    }
}

__global__ __launch_bounds__(256) void n_hgrn(const bf16* Zq, const float* LF, const bf16* Zi, float* Oraw) {
    __shared__ float qs[2][128], fs[2][128], is[2][32], red[8][32];
    const int vq = blockIdx.x & 3, h = (blockIdx.x >> 2) & 3, b = blockIdx.x >> 4;
    const int tid = threadIdx.x, kg = tid >> 5, v = tid & 31;
    float S[16];
#pragma unroll
    for (int j = 0; j < 16; ++j) S[j] = 0.f;
    for (int t = 0; t < SEQ; ++t) {
        const size_t row = (size_t)b * SEQ + t; const int bb = t & 1;
        if (tid < 128) { qs[bb][tid] = bf2f(Zq[row * 512 + h * 128 + tid]); fs[bb][tid] = __expf(LF[row * 512 + h * 128 + tid]); }
        else if (tid < 160) is[bb][tid - 128] = bf2f(Zi[row * 512 + h * 128 + vq * 32 + tid - 128]);
        __syncthreads();
        const float iv = is[bb][v]; float part = 0.f;
#pragma unroll
        for (int j = 0; j < 16; ++j) { const float f = fs[bb][kg * 16 + j]; S[j] = f * S[j] + (1.f - f) * iv; part += S[j] * qs[bb][kg * 16 + j]; }
        red[kg][v] = part;
        __syncthreads();
        if (kg == 0) { float o = 0.f;
#pragma unroll
            for (int q = 0; q < 8; ++q) o += red[q][v];
            Oraw[row * 512 + h * 128 + vq * 32 + v] = o; }
    }
}
__global__ __launch_bounds__(256) void n_hgnorm(const float* Oraw, const bf16* Zg, const float* gain, bf16* YB) {
    const int w = blockIdx.x * 4 + (threadIdx.x >> 6), lane = threadIdx.x & 63;
    const int row = w >> 2, h = w & 3;
    const size_t base = (size_t)row * 512 + h * 128;
    const float o0 = Oraw[base + lane], o1 = Oraw[base + 64 + lane];
    float s = o0 * o0 + o1 * o1;
#pragma unroll
    for (int o_ = 1; o_ < 64; o_ <<= 1) s += __shfl_xor(s, o_);
    const float rstd = rsqrtf(s * (1.f / 128.f) + EPS);
    YB[base + lane] = f2bf(o0 * rstd * gain[h * 128 + lane] * bf2f(Zg[base + lane]));
    YB[base + 64 + lane] = f2bf(o1 * rstd * gain[h * 128 + 64 + lane] * bf2f(Zg[base + 64 + lane]));
}

struct EpiGlu { const bf16* YA; const float* bias; bf16* YA2;
    __device__ void operator()(int row, int col, float v) const { const size_t i = (size_t)row * 512 + col; YA2[i] = f2bf(bf2f(YA[i]) * sigmoidf_(v + bias[col])); } };
struct EpiT { const bf16* Gb; bf16* T;
    __device__ void operator()(int row, int col, float v) const { const size_t i = (size_t)row * 1024 + col; T[i] = f2bf(bf2f(Gb[i]) * v); } };
struct EpiM { const bf16* Ga; const bf16* T; bf16* Mm;
    __device__ void operator()(int row, int col, float v) const { const size_t i = (size_t)row * 1024 + col; Mm[i] = f2bf(bf2f(T[i]) + bf2f(Ga[i]) * v); } };
struct EpiOut { const float* x; const float* g; float* X1; bf16* XG;
    __device__ void operator()(int row, int col, float v) const { const size_t i = (size_t)row * 1024 + col; const float x1 = x[i] + v; X1[i] = x1; XG[i] = f2bf(x1 * g[col]); } };
struct EpiDown { float* X;
    __device__ void operator()(int row, int col, float v) const { const size_t i = (size_t)row * 1024 + col; X[i] = X[i] + v; } };

__global__ __launch_bounds__(256) void n_rowss(const float* x, float* SS) {
    const int row = blockIdx.x * 4 + (threadIdx.x >> 6), lane = threadIdx.x & 63;
    const float* xr = x + (size_t)row * D_MODEL; float s = 0.f;
#pragma unroll
    for (int j = 0; j < 16; ++j) { const float v = xr[lane + 64 * j]; s += v * v; }
#pragma unroll
    for (int o_ = 1; o_ < 64; o_ <<= 1) s += __shfl_xor(s, o_);
    if (lane < 16) SS[(size_t)row * 16 + lane] = lane == 0 ? s : 0.f;
}

__global__ __launch_bounds__(256) void n_ffn_up(const bf16* XG, const float* SS, const float* W, const float* wc, const float* bc, bf16* AF) {
    __shared__ float As[16][68];
    __shared__ float Ws[16][64];
    const int t = threadIdx.x, tx = t & 15, ty = t >> 4;
    const int row0 = blockIdx.y * 64, f0 = blockIdx.x * 32;
    float acc[6][4];
#pragma unroll
    for (int i = 0; i < 6; ++i)
#pragma unroll
        for (int j = 0; j < 4; ++j) acc[i][j] = 0.f;
    for (int k0 = 0; k0 < D_MODEL; k0 += 16) {
        for (int e = t; e < 66 * 16; e += 256) { const int r = e >> 4, kk = e & 15; int gr = row0 - 2 + r; if (gr < 0) gr = 0; As[kk][r] = bf2f(XG[(size_t)gr * D_MODEL + k0 + kk]); }
        { const int kk = t >> 4, c = (t & 15) * 4; const int colg = (c < 32) ? (f0 + c) : (DFF + f0 + c - 32); const f32x4 w = *(const f32x4*)(W + (size_t)(k0 + kk) * NUP + colg);
          Ws[kk][c] = w.x; Ws[kk][c + 1] = w.y; Ws[kk][c + 2] = w.z; Ws[kk][c + 3] = w.w; }
        __syncthreads();
#pragma unroll
        for (int kk = 0; kk < 16; ++kk) {
            float a[6], b[4];
#pragma unroll
            for (int i = 0; i < 6; ++i) a[i] = As[kk][ty * 4 + i];
            b[0] = Ws[kk][tx * 2]; b[1] = Ws[kk][tx * 2 + 1]; b[2] = Ws[kk][32 + tx * 2]; b[3] = Ws[kk][32 + tx * 2 + 1];
#pragma unroll
            for (int i = 0; i < 6; ++i)
#pragma unroll
                for (int j = 0; j < 4; ++j) acc[i][j] += a[i] * b[j];
        }
        __syncthreads();
    }
    float rs[6];
#pragma unroll
    for (int i = 0; i < 6; ++i) { int gr = row0 + 4 * ty - 2 + i; if (gr < 0) gr = 0; float s = 0.f;
#pragma unroll
        for (int q = 0; q < 16; ++q) s += SS[(size_t)gr * 16 + q];
        rs[i] = rsqrtf(s * (1.f / D_MODEL) + EPS); }
#pragma unroll
    for (int i = 0; i < 4; ++i) {
        const int row = row0 + 4 * ty + i, tt = row & (SEQ - 1);
#pragma unroll
        for (int j = 0; j < 2; ++j) {
            const int ff = f0 + tx * 2 + j;
            float hg = bc[ff], hv = bc[DFF + ff];
#pragma unroll
            for (int q = 0; q < 3; ++q) if (tt - 2 + q >= 0) { hg += wc[q * NUP + ff] * acc[i + q][j] * rs[i + q]; hv += wc[q * NUP + DFF + ff] * acc[i + q][2 + j] * rs[i + q]; }
            AF[(size_t)row * DFF + ff] = f2bf(siluf_(hg) * hv);
        }
    }
}

__global__ __launch_bounds__(256) void n_final(float* x, const float* g) {
    const int row = blockIdx.x * 4 + (threadIdx.x >> 6), lane = threadIdx.x & 63;
    float* xr = x + (size_t)row * D_MODEL;
    float v[16]; float s = 0.f;
#pragma unroll
    for (int j = 0; j < 16; ++j) { v[j] = xr[lane + 64 * j]; s += v[j] * v[j]; }
#pragma unroll
    for (int o_ = 1; o_ < 64; o_ <<= 1) s += __shfl_xor(s, o_);
    const float rstd = rsqrtf(s * (1.f / D_MODEL) + EPS);
#pragma unroll
    for (int j = 0; j < 16; ++j) xr[lane + 64 * j] = v[j] * rstd * g[lane + 64 * j];
}

#define LAS __attribute__((address_space(3)))
#define GAS __attribute__((address_space(1)))
typedef short bf16x8 __attribute__((ext_vector_type(8)));
typedef unsigned u32x4 __attribute__((ext_vector_type(4)));
typedef unsigned u32x2 __attribute__((ext_vector_type(2)));
typedef float f32x2 __attribute__((ext_vector_type(2)));

constexpr int NWAVES = 8;
constexpr int RING_BYTES = 131072, EPI_OFF = RING_BYTES, EPI_BYTES = 16384, LDS_BYTES = RING_BYTES + EPI_BYTES;

constexpr size_t WS_W_IN = 0, WS_W_GLU = 9 * MiB, WS_W_PA = WS_W_GLU + MiB / 2, WS_W_PB = WS_W_PA + MiB, WS_W_OUT = WS_W_PB + MiB, WS_W_UP = WS_W_OUT + 2 * MiB, WS_W_DN = WS_W_UP + 11 * MiB;
static_assert(WS_W_DN + (size_t)1024 * DFF * 2 <= 30 * MiB, "weights");
constexpr size_t WS_CTL = 30 * MiB + 65536;
constexpr size_t WS_PM = 31 * MiB, WS_DEC = 39 * MiB, WS_BT = 46 * MiB;
constexpr size_t WS_SS2 = 508 * MiB;
constexpr size_t WS_HF = 400 * MiB, WS_HL = 406 * MiB;

typedef __bf16 bf16x2_t __attribute__((ext_vector_type(2)));
__device__ __forceinline__ unsigned cvt_pk_bf16(float lo, float hi) { f32x2 v = {lo, hi}; bf16x2_t b = __builtin_convertvector(v, bf16x2_t); return __builtin_bit_cast(unsigned, b); }
__device__ __forceinline__ u32x4 pack8(f32x4 a, f32x4 b) { u32x4 w; w.x = cvt_pk_bf16(a[0], a[1]); w.y = cvt_pk_bf16(a[2], a[3]); w.z = cvt_pk_bf16(b[0], b[1]); w.w = cvt_pk_bf16(b[2], b[3]); return w; }
__device__ __forceinline__ void unpack8(u32x4 w, f32x4& a, f32x4& b) {
    a[0] = __uint_as_float(w.x << 16); a[1] = __uint_as_float(w.x & 0xffff0000u); a[2] = __uint_as_float(w.y << 16); a[3] = __uint_as_float(w.y & 0xffff0000u);
    b[0] = __uint_as_float(w.z << 16); b[1] = __uint_as_float(w.z & 0xffff0000u); b[2] = __uint_as_float(w.w << 16); b[3] = __uint_as_float(w.w & 0xffff0000u); }
__device__ __forceinline__ float fsig(float x) { return __builtin_amdgcn_rcpf(1.f + __expf(-x)); }
__device__ __forceinline__ f32x4 fsig4(f32x4 x) { f32x4 r; r[0] = fsig(x[0]); r[1] = fsig(x[1]); r[2] = fsig(x[2]); r[3] = fsig(x[3]); return r; }
__device__ __forceinline__ float fgelu(float x) { const float u2 = 1.5957691216057308f * (x + 0.044715f * x * x * x); return x * fsig(u2); }

namespace pg8 {
constexpr int BM = 256, BK = 64, HALF = 128, HTB = HALF * BK * 2  , NXCD = 8, WGM = 8;
__host__ __device__ __forceinline__ int lds_byte(int r, int c) { const int st = (r >> 4) * 2 + (c >> 5), rr = r & 15, cc = c & 31, ob = rr * 64 + cc * 2; return st * 1024 + (ob ^ (((ob >> 9) & 1) << 5)); }
__host__ __device__ __forceinline__ void stage_rc(int b, int& R, int& C) { const int st = b / 1024, sb = b % 1024, swz = sb ^ (((sb >> 9) & 1) << 5); R = (st >> 1) * 16 + swz / 64; C = (st & 1) * 32 + (swz % 64) / 2; }
__host__ __device__ __forceinline__ int perm32(int rho) { const int n = rho >> 4, i = rho & 15; return 8 * (i >> 2) + 4 * n + (i & 3); }

struct Unit { int pm, pn, pz; };
struct Gemm { const char* A; const char* B; unsigned lda, ldb; long a_pm, a_pz, b_pn, b_pz, hsA, hsB; int nt; };
__device__ __forceinline__ Gemm plain_gemm(const void* A, int lda_el, const void* Bt, int K) {
    Gemm g; g.A = (const char*)A; g.B = (const char*)Bt; g.lda = (unsigned)lda_el * 2u; g.ldb = (unsigned)K * 2u; g.a_pm = 256L * lda_el * 2; g.a_pz = 0; g.b_pn = 256L * K * 2; g.b_pz = 0;
    g.hsA = 128L * lda_el * 2; g.hsB = 128L * K * 2; g.nt = K / BK; return g; }

struct StaticOrder {
    int nM, nN, nwg, G, c;
    __device__ void init(int Mr, int N, int G_, int c_) { nM = Mr / BM; nN = N / BM; nwg = nM * nN; G = G_; c = c_; }
    __device__ bool next(int i, Unit& u) const {
        const long L = (long)i * G + c; if (L >= nwg) return false;
        int wgid = (int)L; { const int q = nwg / NXCD, r = nwg % NXCD, xcd = wgid % NXCD, off = wgid / NXCD; wgid = (xcd < r ? xcd * (q + 1) : r * (q + 1) + (xcd - r) * q) + off; }
        const int nig = WGM * nN, gid = wgid / nig, fm = gid * WGM, gsz = (nM - fm) < WGM ? (nM - fm) : WGM;
        u.pm = fm + ((wgid % nig) % gsz); u.pn = (wgid % nig) / gsz; u.pz = 0; return true;
    }
};

template <class Epi, class Sched>
__device__ __forceinline__ void gemm_phase(LAS unsigned char* lds, LAS unsigned char* es, const Gemm g, const Sched& S, const Epi& E) {
    const int tid = threadIdx.x, wid = __builtin_amdgcn_readfirstlane(tid >> 6), lane = tid & 63, wr = wid >> 2, wc = wid & 3, fr = lane & 15, fq = lane >> 4;
    const int nt = g.nt;
    unsigned voffA[2], voffB[2];
#pragma unroll
    for (int i = 0; i < 2; ++i) { int R, C; stage_rc(tid * 16 + i * 8192, R, C); const int Rb = Epi::PERM ? ((R & ~31) + perm32(R & 31)) : R;
        voffA[i] = (unsigned)R * g.lda + (unsigned)C * 2u; voffB[i] = (unsigned)Rb * g.ldb + (unsigned)C * 2u; }
    const size_t kstep = (size_t)(BK * 2);
    const long hsA = g.hsA, hsB = g.hsB;
    const unsigned ldsw = (unsigned)wid * 1024u;
    const int aoff = lds_byte(wr * 64 + fr, fq * 8), boff = lds_byte(wc * 32 + fr, fq * 8);
#define PG8_SA(b, h) (((b) * 2 + (h)) * HTB)
#define PG8_SB(b, h) ((4 + (b) * 2 + (h)) * HTB)
#define PG8_STAGE(bufoff, gbase, voff) do { _Pragma("unroll") for (int _i = 0; _i < 2; ++_i) \
        __builtin_amdgcn_global_load_lds((const unsigned*)((const char*)(gbase) + (voff)[_i]), (LAS unsigned*)(lds + (bufoff) + ldsw + _i * 8192), 16, 0, 0); } while (0)
#define PG8_LDA(dst, b, h) do { _Pragma("unroll") for (int m = 0; m < 4; ++m) _Pragma("unroll") for (int k = 0; k < 2; ++k) dst[m][k] = *(const LAS bf16x8*)(lds + PG8_SA(b, h) + aoff + m * 2048 + k * 1024); } while (0)
#define PG8_LDB(dst, b, h) do { _Pragma("unroll") for (int n = 0; n < 2; ++n) _Pragma("unroll") for (int k = 0; k < 2; ++k) dst[n][k] = *(const LAS bf16x8*)(lds + PG8_SB(b, h) + boff + n * 2048 + k * 1024); } while (0)
#define PG8_MMA(ai, bj, At, Bt) do { __builtin_amdgcn_s_setprio(1); _Pragma("unroll") for (int m = 0; m < 4; ++m) _Pragma("unroll") for (int n = 0; n < 2; ++n) _Pragma("unroll") for (int k = 0; k < 2; ++k) \
        acc[ai][bj][m][n] = __builtin_amdgcn_mfma_f32_16x16x32_bf16(Bt[n][k], At[m][k], acc[ai][bj][m][n], 0, 0, 0); __builtin_amdgcn_s_setprio(0); } while (0)
#define PG8_WAIT_V(n) asm volatile("s_waitcnt vmcnt(" #n ")" ::: "memory")
#define PG8_WAIT_L(n) asm volatile("s_waitcnt lgkmcnt(" #n ")" ::: "memory")
#define PG8_BAR __builtin_amdgcn_s_barrier()
#define PG8_SCHED __builtin_amdgcn_sched_barrier(0)
    Unit cur, nxt; int ui = 0;
    if (!S.next(0, cur)) return;
    f32x4 acc[2][2][4][2];
#pragma unroll
    for (int a = 0; a < 2; ++a)
#pragma unroll
        for (int b = 0; b < 2; ++b)
#pragma unroll
            for (int m = 0; m < 4; ++m)
#pragma unroll
                for (int n = 0; n < 2; ++n) acc[a][b][m][n] = (f32x4){0.f, 0.f, 0.f, 0.f};
    bf16x8 At[4][2], B0[2][2], B1[2][2];
    const char* cA = g.A + (long)cur.pm * g.a_pm + (long)cur.pz * g.a_pz; const char* cB = g.B + (long)cur.pn * g.b_pn + (long)cur.pz * g.b_pz;
    PG8_STAGE(PG8_SB(0, 0), cB, voffB); PG8_STAGE(PG8_SB(0, 1), cB + hsB, voffB); PG8_STAGE(PG8_SA(0, 0), cA, voffA); PG8_STAGE(PG8_SA(0, 1), cA + hsA, voffA);
    if (wr == 1) PG8_BAR;
    PG8_WAIT_V(2); PG8_BAR;
    PG8_STAGE(PG8_SB(1, 0), cB + kstep, voffB); PG8_STAGE(PG8_SA(1, 0), cA + kstep, voffA); PG8_STAGE(PG8_SB(1, 1), cB + hsB + kstep, voffB);
    PG8_WAIT_V(6); PG8_BAR;
    for (;;) {
        const bool has_next = S.next(ui + 1, nxt);
        const char* nA = has_next ? g.A + (long)nxt.pm * g.a_pm + (long)nxt.pz * g.a_pz : cA; const char* nB = has_next ? g.B + (long)nxt.pn * g.b_pn + (long)nxt.pz * g.b_pz : cB;
        for (int t = 0; t < nt; t += 2) {
            const bool last = (t == nt - 2);
            const char* a1 = cA + (size_t)(t + 1) * kstep;
            const char* a2 = last ? nA : cA + (size_t)(t + 2) * kstep; const char* b2 = last ? nB : cB + (size_t)(t + 2) * kstep;
            const char* a3 = a2 + kstep; const char* b3 = b2 + kstep;
            PG8_LDB(B0, 0, 0); PG8_LDB(B1, 0, 1); PG8_SCHED; PG8_LDA(At, 0, 0); PG8_STAGE(PG8_SA(1, 1), a1 + hsA, voffA);
            PG8_WAIT_V(8); PG8_WAIT_L(0); PG8_BAR; PG8_MMA(0, 0, At, B0); PG8_MMA(0, 1, At, B1); PG8_BAR; PG8_SCHED;
            PG8_LDA(At, 0, 1); PG8_STAGE(PG8_SB(0, 0), b2, voffB); PG8_STAGE(PG8_SB(0, 1), b2 + hsB, voffB); PG8_STAGE(PG8_SA(0, 0), a2, voffA);
            PG8_WAIT_V(8); PG8_WAIT_L(0); PG8_BAR; PG8_MMA(1, 0, At, B0); PG8_MMA(1, 1, At, B1); PG8_BAR; PG8_SCHED;
            PG8_LDB(B0, 1, 0); PG8_LDB(B1, 1, 1); PG8_SCHED; PG8_LDA(At, 1, 0); PG8_STAGE(PG8_SA(0, 1), a2 + hsA, voffA);
            PG8_WAIT_V(8); PG8_WAIT_L(0); PG8_BAR; PG8_MMA(0, 0, At, B0); PG8_MMA(0, 1, At, B1); PG8_BAR; PG8_SCHED;
            PG8_LDA(At, 1, 1); PG8_STAGE(PG8_SB(1, 0), b3, voffB); PG8_STAGE(PG8_SB(1, 1), b3 + hsB, voffB); PG8_STAGE(PG8_SA(1, 0), a3, voffA);
            PG8_WAIT_V(8); PG8_WAIT_L(0); PG8_BAR; PG8_MMA(1, 0, At, B0); PG8_MMA(1, 1, At, B1); PG8_BAR; PG8_SCHED;
        }
        if (wr == 0) PG8_BAR;
        E(acc, cur, wr, wc, fr, fq, wid, lane, es);
        if (!has_next) break;
#pragma unroll
        for (int a = 0; a < 2; ++a)
#pragma unroll
            for (int b = 0; b < 2; ++b)
#pragma unroll
                for (int m = 0; m < 4; ++m)
#pragma unroll
                    for (int n = 0; n < 2; ++n) acc[a][b][m][n] = (f32x4){0.f, 0.f, 0.f, 0.f};
        cur = nxt; cA = nA; cB = nB; ++ui;
        if (wr == 1) PG8_BAR;
    }
    PG8_WAIT_V(0);
    PG8_BAR;
#undef PG8_SA
#undef PG8_SB
#undef PG8_STAGE
#undef PG8_LDA
#undef PG8_LDB
#undef PG8_MMA
#undef PG8_WAIT_V
#undef PG8_WAIT_L
#undef PG8_BAR
#undef PG8_SCHED
}
}

using pg8::Unit;
#define EPI_ARGS f32x4 (&acc)[2][2][4][2], const Unit& u, int wr, int wc, int fr, int fq, int wid, int lane, LAS unsigned char* es
#define FOR_AI_M _Pragma("unroll") for (int ai = 0; ai < 2; ++ai) _Pragma("unroll") for (int m = 0; m < 4; ++m)
#define FOR_BJ _Pragma("unroll") for (int bj = 0; bj < 2; ++bj)

template <int ACT> __device__ __forceinline__ f32x4 act4(f32x4 x) {
    if (ACT == 1) { f32x4 r; _Pragma("unroll") for (int e = 0; e < 4; ++e) r[e] = x[e] * fsig(x[e]) * 0.08838834764831845f; return r; }
    if (ACT == 2) { f32x4 r; _Pragma("unroll") for (int e = 0; e < 4; ++e) r[e] = x[e] * fsig(x[e]); return r; }
    if (ACT == 3) return fsig4(x);
    return x;
}
template <int ACT> __device__ __forceinline__ void store_tile_bf16(const f32x4 (&acc)[2][2][4][2], bf16* dst, int ld, int rowb, int colb) {
    FOR_AI_M { bf16* rp = dst + (size_t)(rowb + ai * 128 + m * 16) * ld + colb;
        FOR_BJ *(u32x4*)(rp + bj * 128) = pack8(act4<ACT>(acc[ai][bj][m][0]), act4<ACT>(acc[ai][bj][m][1])); }
}
struct EpiP1f { static constexpr bool PERM = true;
    bf16 *UA, *Zq, *Zi, *Zg, *Ga, *Gb; float* LF; const float* LB;
    __device__ __forceinline__ void operator()(EPI_ARGS) const {
        const int rowb = u.pm * 256 + wr * 64 + fr, cb = wc * 32 + 8 * fq, pn = u.pn;
        if (pn < 2) {
            FOR_AI_M { const int row = rowb + ai * 128 + m * 16;
                FOR_BJ { const int col = pn * 256 + bj * 128 + cb; const int g = col >> 4, h0 = col & 15;
                    *(u32x4*)(UA + ((size_t)g * 512 + (row >> 6)) * UAK + (row & 63) * 16 + h0) = pack8(acc[ai][bj][m][0], acc[ai][bj][m][1]); } }
        } else if (pn < 4) store_tile_bf16<1>(acc, Zq, 512, rowb, (pn - 2) * 256 + cb);
        else if (pn < 6) {
            const int c0 = (pn - 4) * 256 + cb;
            f32x4 lb[2][2];
            FOR_BJ { lb[bj][0] = *(const f32x4*)(LB + c0 + bj * 128); lb[bj][1] = *(const f32x4*)(LB + c0 + bj * 128 + 4); }
            FOR_AI_M { float* rp = LF + (size_t)(rowb + ai * 128 + m * 16) * 512 + c0;
                FOR_BJ { _Pragma("unroll") for (int n = 0; n < 2; ++n) { f32x4 o; const f32x4 x = acc[ai][bj][m][n];
                    _Pragma("unroll") for (int e = 0; e < 4; ++e) { const float l = lb[bj][n][e]; o[e] = __logf(l + (1.f - l) * fsig(x[e])); }
                    *(f32x4*)(rp + bj * 128 + 4 * n) = o; } } }
        } else if (pn < 8) store_tile_bf16<0>(acc, Zi, 512, rowb, (pn - 6) * 256 + cb);
        else if (pn < 10) store_tile_bf16<2>(acc, Zg, 512, rowb, (pn - 8) * 256 + cb);
        else if (pn < 14) store_tile_bf16<3>(acc, Ga, 1024, rowb, (pn - 10) * 256 + cb);
        else store_tile_bf16<3>(acc, Gb, 1024, rowb, (pn - 14) * 256 + cb);
    }
};
struct EpiGluf { static constexpr bool PERM = true; const bf16* YA; const float* bias; bf16* YA2;
    __device__ __forceinline__ void operator()(EPI_ARGS) const {
        const int rowb = u.pm * 256 + wr * 64 + fr, cb = u.pn * 256 + wc * 32 + 8 * fq;
        f32x4 bv[2][2]; FOR_BJ { bv[bj][0] = *(const f32x4*)(bias + cb + bj * 128); bv[bj][1] = *(const f32x4*)(bias + cb + bj * 128 + 4); }
        FOR_AI_M { const size_t o = (size_t)(rowb + ai * 128 + m * 16) * 512 + cb;
            FOR_BJ { f32x4 a0, a1; unpack8(*(const u32x4*)(YA + o + bj * 128), a0, a1);
                *(u32x4*)(YA2 + o + bj * 128) = pack8(a0 * fsig4(acc[ai][bj][m][0] + bv[bj][0]), a1 * fsig4(acc[ai][bj][m][1] + bv[bj][1])); } }
    }
};
struct EpiTf { static constexpr bool PERM = true; const bf16* Gb; bf16* T;
    __device__ __forceinline__ void operator()(EPI_ARGS) const {
        const int rowb = u.pm * 256 + wr * 64 + fr, cb = u.pn * 256 + wc * 32 + 8 * fq;
        FOR_AI_M { const size_t o = (size_t)(rowb + ai * 128 + m * 16) * 1024 + cb;
            FOR_BJ { f32x4 a0, a1; unpack8(*(const u32x4*)(Gb + o + bj * 128), a0, a1); *(u32x4*)(T + o + bj * 128) = pack8(a0 * acc[ai][bj][m][0], a1 * acc[ai][bj][m][1]); } }
    }
};
struct EpiMf { static constexpr bool PERM = true; const bf16* Ga; const bf16* T; bf16* Mm;
    __device__ __forceinline__ void operator()(EPI_ARGS) const {
        const int rowb = u.pm * 256 + wr * 64 + fr, cb = u.pn * 256 + wc * 32 + 8 * fq;
        FOR_AI_M { const size_t o = (size_t)(rowb + ai * 128 + m * 16) * 1024 + cb;
            FOR_BJ { f32x4 a0, a1, t0, t1; unpack8(*(const u32x4*)(Ga + o + bj * 128), a0, a1); unpack8(*(const u32x4*)(T + o + bj * 128), t0, t1);
                *(u32x4*)(Mm + o + bj * 128) = pack8(t0 + a0 * acc[ai][bj][m][0], t1 + a1 * acc[ai][bj][m][1]); } }
    }
};
struct EpiOutf { static constexpr bool PERM = true; const float* x; const float* g; float* X1; bf16* XG; float* SS;
    __device__ __forceinline__ void operator()(EPI_ARGS) const {
        const int rowb = u.pm * 256 + wr * 64 + fr, cb = u.pn * 256 + wc * 32 + 8 * fq;
        f32x4 gv[2][2]; FOR_BJ { gv[bj][0] = *(const f32x4*)(g + cb + bj * 128); gv[bj][1] = *(const f32x4*)(g + cb + bj * 128 + 4); }
        FOR_AI_M { const int row = rowb + ai * 128 + m * 16; const size_t o = (size_t)row * 1024 + cb; float s = 0.f;
            FOR_BJ { const f32x4 x0 = *(const f32x4*)(x + o + bj * 128) + acc[ai][bj][m][0], x1 = *(const f32x4*)(x + o + bj * 128 + 4) + acc[ai][bj][m][1];
                *(f32x4*)(X1 + o + bj * 128) = x0; *(f32x4*)(X1 + o + bj * 128 + 4) = x1;
                *(u32x4*)(XG + o + bj * 128) = pack8(x0 * gv[bj][0], x1 * gv[bj][1]);
                s += (x0[0] * x0[0] + x0[1] * x0[1]) + (x0[2] * x0[2] + x0[3] * x0[3]) + (x1[0] * x1[0] + x1[1] * x1[1]) + (x1[2] * x1[2] + x1[3] * x1[3]); }
            s += __shfl_xor(s, 16); s += __shfl_xor(s, 32);
            if (fq == 0) SS[(size_t)row * 16 + u.pn * 4 + wc] = s; }
    }
};
struct EpiDownf { static constexpr bool PERM = true; float* X; float* SS;
    __device__ __forceinline__ void operator()(EPI_ARGS) const {
        const int rowb = u.pm * 256 + wr * 64 + fr, cb = u.pn * 256 + wc * 32 + 8 * fq;
        FOR_AI_M { const int row = rowb + ai * 128 + m * 16; const size_t o = (size_t)row * 1024 + cb; float s = 0.f;
            FOR_BJ { const f32x4 x0 = *(const f32x4*)(X + o + bj * 128) + acc[ai][bj][m][0], x1 = *(const f32x4*)(X + o + bj * 128 + 4) + acc[ai][bj][m][1];
                *(f32x4*)(X + o + bj * 128) = x0; *(f32x4*)(X + o + bj * 128 + 4) = x1;
                s += (x0[0] * x0[0] + x0[1] * x0[1]) + (x0[2] * x0[2] + x0[3] * x0[3]) + (x1[0] * x1[0] + x1[1] * x1[1]) + (x1[2] * x1[2] + x1[3] * x1[3]); }
            s += __shfl_xor(s, 16); s += __shfl_xor(s, 32);
            if (fq == 0) SS[(size_t)row * 16 + u.pn * 4 + wc] = s; }
    }
};
__device__ __forceinline__ f32x4 dpp4_shr(f32x4 old, f32x4 src, int which) { f32x4 r;
#pragma unroll
    for (int e = 0; e < 4; ++e) { const int o = __float_as_int(old[e]), s = __float_as_int(src[e]);
        r[e] = __int_as_float(which == 1 ? __builtin_amdgcn_update_dpp(o, s, 0x111, 0xf, 0xf, false) : __builtin_amdgcn_update_dpp(o, s, 0x112, 0xf, 0xf, false)); }
    return r; }
__device__ __forceinline__ f32x4 dpp4_ror(f32x4 src, int which) { f32x4 r;
#pragma unroll
    for (int e = 0; e < 4; ++e) { const int s = __float_as_int(src[e]);
        r[e] = __int_as_float(which == 1 ? __builtin_amdgcn_update_dpp(s, s, 0x121, 0xf, 0xf, false) : __builtin_amdgcn_update_dpp(s, s, 0x122, 0xf, 0xf, false)); }
    return r; }
struct EpiUpf { static constexpr bool PERM = true; const float* SS; const float* wcv; const float* bcv; bf16* AF; float* HF; float* HL;
    __device__ __forceinline__ void operator()(EPI_ARGS) const {
        LAS float* rs = (LAS float*)es; LAS float* xch = (LAS float*)(es + 1024);
        const int tid = wid * 64 + lane;
        { const int r = tid >> 1, hf = tid & 1; const f32x4* p = (const f32x4*)(SS + (size_t)(u.pm * 256 + r) * 16 + hf * 8); const f32x4 a = p[0], b = p[1];
          float s = (a[0] + a[1]) + (a[2] + a[3]) + (b[0] + b[1]) + (b[2] + b[3]); s += __shfl_xor(s, 1); if (hf == 0) rs[r] = rsqrtf(s * (1.f / D_MODEL) + EPS); }
        asm volatile("s_waitcnt lgkmcnt(0)" ::: "memory"); __builtin_amdgcn_s_barrier(); asm volatile("" ::: "memory");
        FOR_AI_M { const float r_ = rs[ai * 128 + wr * 64 + m * 16 + fr]; FOR_BJ { acc[ai][bj][m][0] = acc[ai][bj][m][0] * r_; acc[ai][bj][m][1] = acc[ai][bj][m][1] * r_; } }
        const int colb = u.pn * 256 + wc * 32 + 8 * fq;
        if (fr >= 14) {
#pragma unroll
            for (int ai = 0; ai < 2; ++ai) { LAS f32x4* d = (LAS f32x4*)(xch + (size_t)(((((2 * ai + wr) * 4 + wc) * 2 + (fr - 14)) * 4 + fq) * 16));
                d[0] = acc[ai][0][3][0]; d[1] = acc[ai][0][3][1]; d[2] = acc[ai][1][3][0]; d[3] = acc[ai][1][3][1]; }
            if (wr == 1) { float* hp = HL + ((size_t)u.pm * 2 + (fr - 14)) * NUP + colb; FOR_BJ { *(f32x4*)(hp + bj * 128) = acc[1][bj][3][0]; *(f32x4*)(hp + bj * 128 + 4) = acc[1][bj][3][1]; } }
        }
        if (fr < 2 && wr == 0) { float* hp = HF + ((size_t)u.pm * 2 + fr) * NUP + colb; FOR_BJ { *(f32x4*)(hp + bj * 128) = acc[0][bj][0][0]; *(f32x4*)(hp + bj * 128 + 4) = acc[0][bj][0][1]; } }
        asm volatile("s_waitcnt lgkmcnt(0)" ::: "memory"); __builtin_amdgcn_s_barrier(); asm volatile("" ::: "memory");
        const int ffb = u.pn * 128 + wc * 32 + 8 * fq;
#pragma unroll
        for (int n = 0; n < 2; ++n) {
            const int ff = ffb + 4 * n;
            const f32x4 wg0 = *(const f32x4*)(wcv + ff), wg1 = *(const f32x4*)(wcv + NUP + ff), wg2 = *(const f32x4*)(wcv + 2 * NUP + ff), bg = *(const f32x4*)(bcv + ff);
            const f32x4 wv0 = *(const f32x4*)(wcv + DFF + ff), wv1 = *(const f32x4*)(wcv + NUP + DFF + ff), wv2 = *(const f32x4*)(wcv + 2 * NUP + DFF + ff), bv = *(const f32x4*)(bcv + DFF + ff);
#pragma unroll
            for (int ai = 0; ai < 2; ++ai) {
                const int s = 2 * ai + wr;
                f32x4 g1 = {0.f, 0.f, 0.f, 0.f}, g2 = g1, v1 = g1, v2 = g1;
                if (s > 0) { const LAS f32x4* r14 = (const LAS f32x4*)(xch + (size_t)(((((s - 1) * 4 + wc) * 2 + 0) * 4 + fq) * 16)); const LAS f32x4* r15 = r14 + 16;
                    g1 = r15[n]; v1 = r15[2 + n]; g2 = fr == 0 ? r14[n] : r15[n]; v2 = fr == 0 ? r14[2 + n] : r15[2 + n]; }
#pragma unroll
                for (int m = 0; m < 4; ++m) {
                    const f32x4 cg = acc[ai][0][m][n], cv = acc[ai][1][m][n];
                    if (m > 0) { g1 = dpp4_ror(acc[ai][0][m - 1][n], 1); g2 = dpp4_ror(acc[ai][0][m - 1][n], 2); v1 = dpp4_ror(acc[ai][1][m - 1][n], 1); v2 = dpp4_ror(acc[ai][1][m - 1][n], 2); }
                    const f32x4 pg1 = dpp4_shr(g1, cg, 1), pg2 = dpp4_shr(g2, cg, 2), pv1 = dpp4_shr(v1, cv, 1), pv2 = dpp4_shr(v2, cv, 2);
                    const f32x4 hg = bg + wg0 * pg2 + wg1 * pg1 + wg2 * cg, hv = bv + wv0 * pv2 + wv1 * pv1 + wv2 * cv;
                    f32x4 o; _Pragma("unroll") for (int e = 0; e < 4; ++e) o[e] = hg[e] * fsig(hg[e]) * hv[e];
                    u32x2 w; w.x = cvt_pk_bf16(o[0], o[1]); w.y = cvt_pk_bf16(o[2], o[3]);
                    *(u32x2*)(AF + (size_t)(u.pm * 256 + ai * 128 + wr * 64 + m * 16 + fr) * DFF + ff) = w;
                }
            }
        }
    }
};
typedef GAS unsigned gu32;
#define RLX_AGENT __ATOMIC_RELAXED, __HIP_MEMORY_SCOPE_AGENT
#define XB_TMO      128
#define XB_XCNT(j)  (256  + 64 * (j))
#define XB_XSUB(j)  (1280 + 64 * (j))
#define XB_XGEN(j)  (2304 + 64 * (j))
#define XB_TOP      3328
#define XB_TOPGEN   3392
#define XCD_BAR_WORDS 3456
#define XB_SPIN_CAP (1u << 18)
__device__ __forceinline__ unsigned xb_ld(unsigned* p)              { return __hip_atomic_load(p, __ATOMIC_RELAXED, __HIP_MEMORY_SCOPE_AGENT); }
__device__ __forceinline__ unsigned xb_add(unsigned* p, unsigned v) { return __hip_atomic_fetch_add(p, v, __ATOMIC_RELAXED, __HIP_MEMORY_SCOPE_AGENT); }
__device__ __forceinline__ unsigned xb_xcc_id() { return (unsigned)__builtin_amdgcn_s_getreg((3 << 11) | 20) & 0xFu; }
#define XB_SPIN(cond, bar) do { unsigned _sp = 0; while (cond) { __builtin_amdgcn_s_sleep(1); \
    if ((++_sp & 255u) == 0u) { if (xb_ld(&(bar)[XB_TMO])) break; if (_sp > XB_SPIN_CAP) { atomicAdd(&(bar)[XB_TMO], 1u); break; } } } } while (0)
struct XcdBarrier { unsigned* bar; unsigned x; volatile LAS unsigned* st; };
__device__ __forceinline__ XcdBarrier xcd_barrier_post(unsigned* bar, volatile LAS unsigned* st) {
    XcdBarrier b; b.bar = bar; b.x = xb_xcc_id(); b.st = st;
    if (threadIdx.x == 0) (void)xb_add(&bar[XB_XCNT(b.x)], 1u);
    return b;
}
__device__ __forceinline__ void xcd_barrier_complete(unsigned* bar, unsigned x, unsigned& nloc, unsigned& nx) {
    const unsigned G = gridDim.x * gridDim.y * gridDim.z;
    unsigned sum, cnt, mine, sp = 0u;
    for (;;) {
        sum = 0u; cnt = 0u; mine = 0u;
#pragma unroll
        for (unsigned j = 0; j < 16; ++j) { const unsigned c = xb_ld(&bar[XB_XCNT(j)]); sum += c; cnt += (c > 0u) ? 1u : 0u; mine = (j == x) ? c : mine; }
        if (sum == G) break;
        __builtin_amdgcn_s_sleep(1);
        if ((++sp & 255u) == 0u) { if (xb_ld(&bar[XB_TMO])) break; if (sp > XB_SPIN_CAP) { atomicAdd(&bar[XB_TMO], 1u); break; } }
    }
    nloc = mine > 0u ? mine : 1u; nx = cnt > 0u ? cnt : 1u;
}
__device__ __forceinline__ void xcd_barrier(const XcdBarrier& b) {
    asm volatile("s_waitcnt vmcnt(0)" ::: "memory");
    __syncthreads();
    if (threadIdx.x == 0) {
        unsigned* bar = b.bar;
        __builtin_amdgcn_s_waitcnt(0);
        unsigned nloc = b.st[0], nx = b.st[1];
        if (nloc == 0u) { xcd_barrier_complete(bar, b.x, nloc, nx); b.st[0] = nloc; b.st[1] = nx; }
        const unsigned old = xb_add(&bar[XB_XSUB(b.x)], 1u);
        const unsigned gen = old / nloc;
        if (old + 1u == (gen + 1u) * nloc) {
            __builtin_amdgcn_fence(__ATOMIC_RELEASE, "agent");
            asm volatile("s_waitcnt vmcnt(0)" ::: "memory");
            const unsigned og = xb_add(&bar[XB_TOP], 1u);
            const unsigned tg = og / nx;
            if (og + 1u == (tg + 1u) * nx) xb_add(&bar[XB_TOPGEN], 1u);
            else XB_SPIN(xb_ld(&bar[XB_TOPGEN]) == tg, bar);
            __builtin_amdgcn_fence(__ATOMIC_ACQUIRE, "agent");
            xb_add(&bar[XB_XGEN(b.x)], 1u);
            asm volatile("s_waitcnt vmcnt(0)" ::: "memory");
        } else {
            XB_SPIN(xb_ld(&bar[XB_XGEN(b.x)]) == gen, bar);
            __builtin_amdgcn_fence(__ATOMIC_ACQUIRE, "agent");
            asm volatile("s_waitcnt vmcnt(0)" ::: "memory");
        }
    }
    __syncthreads();
}

#define LDS_WAIT() asm volatile("s_waitcnt lgkmcnt(0)" ::: "memory")
__device__ __forceinline__ unsigned pk2(float lo, float hi) { return (unsigned)f2bf(lo) | ((unsigned)f2bf(hi) << 16); }
__device__ __forceinline__ void p0_transpose_item(const float* W, int K, int N, bf16* WT, int k0, int n0, int drow0, LAS float* scr, int lane) {
#pragma unroll 8
    for (int i = 0; i < 32; ++i) { const int kk = 2 * i + (lane >> 5); scr[kk * 33 + (lane & 31)] = W[(size_t)(k0 + kk) * N + n0 + (lane & 31)]; }
    LDS_WAIT(); asm volatile("" ::: "memory");
    const int c = lane & 7;
#pragma unroll
    for (int j = 0; j < 4; ++j) { const int n = (lane >> 3) + 8 * j; const LAS float* s = scr + (8 * c) * 33 + n;
        u32x4 o; o.x = pk2(s[0 * 33], s[1 * 33]); o.y = pk2(s[2 * 33], s[3 * 33]); o.z = pk2(s[4 * 33], s[5 * 33]); o.w = pk2(s[6 * 33], s[7 * 33]);
        *(u32x4*)(WT + (size_t)(drow0 + n) * K + k0 + 8 * c) = o; }
    LDS_WAIT(); asm volatile("" ::: "memory");
}

struct Args { const float* in[24]; float* out; unsigned char* ws; int ph_lo, ph_hi, probe, pad; };

struct Ptrs {
    bf16 *Win, *Wglu, *Wpa, *Wpb, *Wout, *Wup, *Wdn;
    bf16 *XN, *Zq, *Zi, *Zg, *UA, *Ga, *Gb, *YA, *YB, *YA2, *T, *Mm, *XG, *AF;
    float *LB, *LF, *SS1, *SS2, *HF, *HL;
};


struct PtrsLazy { unsigned char* ws; unsigned char* dob;
#define PL(name, type, base, off) __device__ __forceinline__ type* name() const { return (type*)(base + (off)); }
    PL(Win_, bf16, ws, WS_W_IN) PL(Wglu_, bf16, ws, WS_W_GLU) PL(Wpa_, bf16, ws, WS_W_PA) PL(Wpb_, bf16, ws, WS_W_PB) PL(Wout_, bf16, ws, WS_W_OUT) PL(Wup_, bf16, ws, WS_W_UP) PL(Wdn_, bf16, ws, WS_W_DN)
    PL(XN_, bf16, ws, WS_XN) PL(Zq_, bf16, ws, WS_ZQ) PL(Zi_, bf16, ws, WS_ZI) PL(Zg_, bf16, ws, WS_ZG) PL(UA_, bf16, ws, WS_UA) PL(Ga_, bf16, ws, WS_GA) PL(Gb_, bf16, ws, WS_GB)
    PL(YA_, bf16, dob, DO_YA) PL(YB_, bf16, dob, DO_YB) PL(YA2_, bf16, dob, DO_YA2) PL(T_, bf16, ws, WS_T) PL(Mm_, bf16, ws, WS_MM) PL(XG_, bf16, ws, WS_XG) PL(AF_, bf16, ws, WS_AF)
    PL(LB_, float, ws, WS_SMALL) PL(LF_, float, ws, WS_LF) PL(SS1_, float, ws, WS_SS1) PL(SS2_, float, ws, WS_SS2) PL(HF_, float, ws, WS_HF) PL(HL_, float, ws, WS_HL)
#undef PL
};
__device__ __forceinline__ void phase_prologue(const Args& a, const PtrsLazy& P, LAS unsigned char* lds, int vcu, int G, int wave, int lane) {
    LAS float* scr = (LAS float*)(lds + wave * 16384);
    const int gw = vcu * NWAVES + wave, NGW = G * NWAVES;
    constexpr int I_IN = 16 * (NIN / 32), I_GLU = 8 * 16, I_PA = 8 * 32, I_PB = 8 * 32, I_OUT = 16 * 32, I_UP = 16 * (NUP / 32), I_DN = (DFF / 64) * 32;
    constexpr int NITEMS = I_IN + I_GLU + I_PA + I_PB + I_OUT + I_UP + I_DN;
    for (int it = gw; it < NITEMS; it += NGW) {
        int r = it;
        if (r < I_IN) { const int nb = r % (NIN / 32), kb = r / (NIN / 32); p0_transpose_item(a.in[2], 1024, NIN, P.Win_(), kb * 64, nb * 32, nb * 32, scr, lane); continue; } r -= I_IN;
        if (r < I_GLU) { const int nb = r % 16, kb = r / 16; p0_transpose_item(a.in[11], 512, 512, P.Wglu_(), kb * 64, nb * 32, nb * 32, scr, lane); continue; } r -= I_GLU;
        if (r < I_PA) { const int nb = r % 32, kb = r / 32; p0_transpose_item(a.in[15], 512, 1024, P.Wpa_(), kb * 64, nb * 32, nb * 32, scr, lane); continue; } r -= I_PA;
        if (r < I_PB) { const int nb = r % 32, kb = r / 32; p0_transpose_item(a.in[16], 512, 1024, P.Wpb_(), kb * 64, nb * 32, nb * 32, scr, lane); continue; } r -= I_PB;
        if (r < I_OUT) { const int nb = r % 32, kb = r / 32; p0_transpose_item(a.in[17], 1024, 1024, P.Wout_(), kb * 64, nb * 32, nb * 32, scr, lane); continue; } r -= I_OUT;
        if (r < I_UP) { const int nb = r % (NUP / 32), kb = r / (NUP / 32); const int n0 = nb * 32; const int isv = n0 >= DFF ? 1 : 0, ff = n0 - isv * DFF;
            p0_transpose_item(a.in[19], 1024, NUP, P.Wup_(), kb * 64, n0, (ff >> 7) * 256 + isv * 128 + (ff & 127), scr, lane); continue; } r -= I_UP;
        { const int nb = r % 32, kb = r / 32; p0_transpose_item(a.in[22], DFF, 1024, P.Wdn_(), kb * 64, nb * 32, nb * 32, scr, lane); }
    }
    const float* gm = a.in[1];
    for (int row = gw; row < M; row += NGW) {
        const f32x4* xr = (const f32x4*)(a.in[0] + (size_t)row * D_MODEL) + lane;
        f32x4 v[4]; float s = 0.f;
#pragma unroll
        for (int j = 0; j < 4; ++j) { v[j] = xr[64 * j]; s += (v[j][0] * v[j][0] + v[j][1] * v[j][1]) + (v[j][2] * v[j][2] + v[j][3] * v[j][3]); }
#pragma unroll
        for (int o_ = 1; o_ < 64; o_ <<= 1) s += __shfl_xor(s, o_);
        const float rstd = rsqrtf(s * (1.f / D_MODEL) + EPS);
        u32x2* o8 = (u32x2*)(P.XN_() + (size_t)row * D_MODEL) + lane;
#pragma unroll
        for (int j = 0; j < 4; ++j) { const f32x4 gv = *((const f32x4*)gm + lane + 64 * j); u32x2 w; w.x = cvt_pk_bf16(v[j][0] * rstd * gv[0], v[j][1] * rstd * gv[1]); w.y = cvt_pk_bf16(v[j][2] * rstd * gv[2], v[j][3] * rstd * gv[3]); o8[64 * j] = w; }
    }
    if (vcu == 0) { const int c = wave * 64 + lane; const float l0 = a.in[13][c], l1 = a.in[13][HGW + c]; P.LB_()[c] = 1.f / (1.f + expf(l1 - l0)); }
}

__device__ __forceinline__ void phase_fixup(const Args& a, const PtrsLazy& P, int vcu, int G, int tid) {
    const float* wcv = a.in[20]; const float* bcv = a.in[21];
    const int total = 128 * 2 * DFF;
    for (int e = vcu * 512 + tid; e < total; e += G * 512) {
        const int ff = e % DFF, r = (e / DFF) & 1, pm = e / (2 * DFF);
        if ((pm & 7) == 0) continue;
        const int cg = (ff >> 7) * 256 + (ff & 127), cv = cg + 128;
        const float* hl = P.HL_() + (size_t)(pm - 1) * 2 * NUP; const float* hf = P.HF_() + (size_t)pm * 2 * NUP;
        float g2, g1, g0, v2, v1, v0;
        if (r == 0) { g2 = hl[cg]; g1 = hl[NUP + cg]; g0 = hf[cg]; v2 = hl[cv]; v1 = hl[NUP + cv]; v0 = hf[cv]; }
        else { g2 = hl[NUP + cg]; g1 = hf[cg]; g0 = hf[NUP + cg]; v2 = hl[NUP + cv]; v1 = hf[cv]; v0 = hf[NUP + cv]; }
        const float hg = bcv[ff] + wcv[ff] * g2 + wcv[NUP + ff] * g1 + wcv[2 * NUP + ff] * g0;
        const float hv = bcv[DFF + ff] + wcv[DFF + ff] * v2 + wcv[NUP + DFF + ff] * v1 + wcv[2 * NUP + DFF + ff] * v0;
        P.AF_()[(size_t)(pm * 256 + r) * DFF + ff] = f2bf(hg * fsig(hg) * hv);
    }
}
__device__ __forceinline__ void phase_final(const Args& a, const PtrsLazy& P, int vcu, int G, int wave, int lane) {
    const int gw = vcu * NWAVES + wave, NGW = G * NWAVES; const float* gf = a.in[23];
    for (int row = gw; row < M; row += NGW) {
        float s = lane < 16 ? P.SS2_()[(size_t)row * 16 + lane] : 0.f;
#pragma unroll
        for (int o_ = 1; o_ < 16; o_ <<= 1) s += __shfl_xor(s, o_);
        s = __shfl(s, 0);
        const float rstd = rsqrtf(s * (1.f / D_MODEL) + EPS);
        f32x4* xr = (f32x4*)(a.out + (size_t)row * D_MODEL) + lane;
#pragma unroll
        for (int j = 0; j < 4; ++j) { const f32x4 gv = *((const f32x4*)gf + lane + 64 * j); xr[64 * j] = xr[64 * j] * rstd * gv; }
    }
}
constexpr size_t DO_SX = 64 * MiB;
constexpr size_t WS_L64 = 30 * MiB + 131072;
constexpr size_t DO_AGG = 96 * MiB, DO_DAGG = 104 * MiB;
__device__ __forceinline__ f32x4 mfma16(bf16x8 a, bf16x8 b, f32x4 c) { return __builtin_amdgcn_mfma_f32_16x16x32_bf16(a, b, c, 0, 0, 0); }
#define BLK_SYNC() do { asm volatile("s_waitcnt lgkmcnt(0)" ::: "memory"); __builtin_amdgcn_s_barrier(); asm volatile("" ::: "memory"); } while (0)

__device__ __forceinline__ void s5_tables_item(const Args& a, bf16* BT, bf16* PM, f32x2* L64, LAS unsigned char* lds, int g, int h, int tid) {
    LAS f32x2* lt = (LAS f32x2*)lds;
    LAS f32x2* bbs = (LAS f32x2*)(lds + 33280);
    LAS f32x2* cw = (LAS f32x2*)(lds + 33280 + 8192);
    LAS bf16* KcL = (LAS bf16*)(lds + 33280 + 8192 + 512);
    if (tid < 64) {
        const int p = tid;
        const double dt = exp((double)a.in[5][g]);
        const double ar = a.in[3][g * 64 + p], ai = a.in[4][g * 64 + p];
        const double mag = exp(ar * dt), ang = ai * dt;
        const double lr = mag * cos(ang), li = mag * sin(ang);
        const double den = ar * ar + ai * ai, nr = lr - 1.0, ni = li;
        const double cor = (nr * ar + ni * ai) / den, coi = (ni * ar - nr * ai) / den;
        for (int hh = 0; hh < 16; ++hh) { const double br = a.in[6][(g * 64 + p) * 16 + hh], bi = a.in[7][(g * 64 + p) * 16 + hh];
            bbs[p * 16 + hh] = (f32x2){(float)(cor * br - coi * bi), (float)(cor * bi + coi * br)}; }
        cw[p] = (f32x2){a.in[8][(g * 16 + h) * 64 + p], a.in[9][(g * 16 + h) * 64 + p]};
        double xr = 1.0, xi = 0.0;
        for (int tau = 0; tau <= 64; ++tau) { lt[tau * 64 + p] = (f32x2){(float)xr, (float)xi}; const double t2 = xr * lr - xi * li; xi = xr * li + xi * lr; xr = t2; }
        if (h == 0) L64[g * 64 + p] = lt[64 * 64 + p];
    }
    for (int e = tid; e < 64 * 16; e += 512) KcL[e] = 0;
    BLK_SYNC();
#pragma unroll
    for (int e = 0; e < 2; ++e) { const int idx = tid * 2 + e, tau = idx >> 4, hp = idx & 15; float s = 0.f;
        for (int p = 0; p < 64; ++p) { const f32x2 c = cw[p], l = lt[tau * 64 + p], b = bbs[p * 16 + hp];
            const float wr_ = c.x * l.x - c.y * l.y, wi_ = c.x * l.y + c.y * l.x; s += wr_ * b.x - wi_ * b.y; }
        KcL[(64 + tau) * 16 + hp] = f2bf(s); }
    BLK_SYNC();
    for (int e = tid; e < 64 * 144; e += 512) { const int t = e / 144, pc = e % 144;
        bf16* dst = BT + ((size_t)(g * 1024 + t * 16 + h)) * UAK + pc * 8;
        u32x4 w;
        if (pc < 128) { const int s = pc >> 1, half = pc & 1; w = *(const LAS u32x4*)(KcL + (t - s + 64) * 16 + half * 8); }
        else { const int p0 = (pc - 128) * 8; float v[8];
#pragma unroll
            for (int q = 0; q < 8; ++q) { const int pp = p0 + q, p = pp & 63; const f32x2 c = cw[p], l = lt[(t + 1) * 64 + p];
                v[q] = pp < 64 ? (c.x * l.x - c.y * l.y) : -(c.x * l.y + c.y * l.x); }
            w.x = cvt_pk_bf16(v[0], v[1]); w.y = cvt_pk_bf16(v[2], v[3]); w.z = cvt_pk_bf16(v[4], v[5]); w.w = cvt_pk_bf16(v[6], v[7]); }
        *(u32x4*)dst = w; }
    for (int e = tid; e < 8 * 128; e += 512) { const int rr = e >> 7, pc = e & 127, pp = 8 * h + rr, p = pp & 63, s = pc >> 1, half = pc & 1;
        const f32x2 l = lt[(63 - s) * 64 + p]; float v[8];
#pragma unroll
        for (int q = 0; q < 8; ++q) { const f32x2 b = bbs[p * 16 + half * 8 + q]; v[q] = pp < 64 ? (l.x * b.x - l.y * b.y) : (l.x * b.y + l.y * b.x); }
        u32x4 w; w.x = cvt_pk_bf16(v[0], v[1]); w.y = cvt_pk_bf16(v[2], v[3]); w.z = cvt_pk_bf16(v[4], v[5]); w.w = cvt_pk_bf16(v[6], v[7]);
        *(u32x4*)(PM + ((size_t)(g * 128 + pp)) * 1024 + s * 16 + half * 8) = w; }
    BLK_SYNC();
}

struct S5Order { int c, G; __device__ bool next(int i, Unit& o) const { const int L = i * G + c; if (L >= 256) return false; o.pz = L >> 3; o.pm = (L >> 2) & 1; o.pn = L & 3; return true; } };
struct OneUnit { Unit u; __device__ bool next(int i, Unit& o) const { if (i > 0) return false; o = u; return true; } };
struct EpiS5sum { static constexpr bool PERM = true; float* Sx;
    __device__ __forceinline__ void operator()(EPI_ARGS) const {
        const int rowb = u.pm * 256 + wr * 64 + fr, cb = wc * 32 + 8 * fq;
        FOR_AI_M { float* rp = Sx + (((size_t)u.pn * 32 + u.pz) * 512 + rowb + ai * 128 + m * 16) * 128 + cb; *(f32x4*)rp = acc[ai][0][m][0]; *(f32x4*)(rp + 4) = acc[ai][0][m][1]; }
    }
};
struct EpiS5main { static constexpr bool PERM = true; const bf16* UA; const float* dsk; bf16* YA;
    __device__ __forceinline__ void operator()(EPI_ARGS) const {
        const int g = u.pz, rowb = u.pm * 256 + wr * 64 + fr;
        FOR_BJ { const int n0 = u.pn * 256 + bj * 128 + wc * 32 + 8 * fq, t = n0 >> 4, h0 = n0 & 15;
            const f32x4 d0 = *(const f32x4*)(dsk + g * 16 + h0), d1 = *(const f32x4*)(dsk + g * 16 + h0 + 4);
            FOR_AI_M { const int r = rowb + ai * 128 + m * 16, b = r >> 5, c = r & 31;
                f32x4 u0, u1; unpack8(*(const u32x4*)(UA + ((size_t)g * 512 + r) * UAK + n0), u0, u1);
                f32x4 y0 = acc[ai][bj][m][0] + d0 * u0, y1 = acc[ai][bj][m][1] + d1 * u1;
                _Pragma("unroll") for (int e = 0; e < 4; ++e) { y0[e] = fgelu(y0[e]); y1[e] = fgelu(y1[e]); }
                *(u32x4*)(YA + ((size_t)(b * SEQ + c * 64 + t)) * 512 + g * 16 + h0) = pack8(y0, y1); } }
    }
};

__device__ __forceinline__ void s5_scan(const f32x2* L64, const float* Sx4, bf16* UA, int gt) {
    const int p = gt & 63, g = (gt >> 6) & 31, b = gt >> 11;
    const f32x2 l = L64[g * 64 + p]; const float lr = l.x, li = l.y;
    const float* sp = Sx4 + ((size_t)g * 512 + b * 32) * 128 + p;
    bf16* up = UA + ((size_t)g * 512 + b * 32) * UAK + 1024 + p;
    float sr[32], si[32];
#pragma unroll
    for (int c = 0; c < 32; ++c) { sr[c] = sp[c * 128]; si[c] = sp[c * 128 + 64]; }
#pragma unroll
    for (int kq = 1; kq < 4; ++kq)
#pragma unroll
        for (int c = 0; c < 32; ++c) { sr[c] += sp[(size_t)kq * 32 * 512 * 128 + c * 128]; si[c] += sp[(size_t)kq * 32 * 512 * 128 + c * 128 + 64]; }
    float xr = 0.f, xi = 0.f;
#pragma unroll
    for (int c = 0; c < 32; ++c) { up[(size_t)c * UAK] = f2bf(xr); up[(size_t)c * UAK + 64] = f2bf(xi);
        const float nr = lr * xr - li * xi + sr[c], ni = lr * xi + li * xr + si[c]; xr = nr; xi = ni; }
}

constexpr int HL_TOT = 0, HL_QT = 2048, HL_KK = HL_QT + 64 * 272, HL_IT = HL_KK + 64 * 272, HL_PT = HL_IT + 128 * 144, HL_KT = HL_PT + 64 * 144, HL_OL = HL_KT + 128 * 144, HL_SSQ = HL_OL + 64 * 128 * 4, HL_END = HL_SSQ + 8 * 64 * 4;
static_assert(HL_END <= RING_BYTES, "hgrn lds");
__device__ __forceinline__ float row16_sum(float s) {
    s += __int_as_float(__builtin_amdgcn_update_dpp(0, __float_as_int(s), 0x128, 0xf, 0xf, false));
    s += __int_as_float(__builtin_amdgcn_update_dpp(0, __float_as_int(s), 0x124, 0xf, 0xf, false));
    s += __int_as_float(__builtin_amdgcn_update_dpp(0, __float_as_int(s), 0x122, 0xf, 0xf, false));
    s += __int_as_float(__builtin_amdgcn_update_dpp(0, __float_as_int(s), 0x121, 0xf, 0xf, false));
    return s; }
struct HgRegs { float lf[16]; unsigned qv[16]; unsigned iv[16]; };
template <bool WANT_Q> __device__ __forceinline__ void hg_load(const float* LF, const bf16* Zq, const bf16* Zi, int unit, int tid, HgRegs& R) {
    const int bh = unit >> 5, c = unit & 31, b = bh >> 2, h = bh & 3, k = tid & 127, seg = tid >> 7;
    const size_t base = ((size_t)b * SEQ + c * 64 + seg * 16) * 512 + h * 128 + k;
#pragma unroll
    for (int j = 0; j < 16; ++j) { R.lf[j] = LF[base + (size_t)j * 512]; R.iv[j] = Zi[base + (size_t)j * 512]; if (WANT_Q) R.qv[j] = Zq[base + (size_t)j * 512]; }
}
__device__ __forceinline__ void hg_scan(LAS unsigned char* lds, int tid, const float (&lf)[16], float (&bc)[16], float& blast) {
    const int k = tid & 127, seg = tid >> 7; LAS float* tot = (LAS float*)(lds + HL_TOT);
    float run = 0.f;
#pragma unroll
    for (int j = 0; j < 16; ++j) { run += lf[j]; bc[j] = run; }
    tot[seg * 128 + k] = run;
    BLK_SYNC();
    const float t0 = tot[k], t1 = tot[128 + k], t2 = tot[256 + k], t3 = tot[384 + k];
    const float off = seg == 0 ? 0.f : seg == 1 ? t0 : seg == 2 ? t0 + t1 : (t0 + t1) + t2;
    blast = ((t0 + t1) + t2) + t3;
#pragma unroll
    for (int j = 0; j < 16; ++j) bc[j] += off;
}
__device__ __forceinline__ void hg_stage_it(const unsigned (&x)[16], LAS unsigned char* lds, int tid) {
    const int v = tid & 127, seg = tid >> 7;
    u32x4 w0, w1; w0.x = x[0] | (x[1] << 16); w0.y = x[2] | (x[3] << 16); w0.z = x[4] | (x[5] << 16); w0.w = x[6] | (x[7] << 16);
    w1.x = x[8] | (x[9] << 16); w1.y = x[10] | (x[11] << 16); w1.z = x[12] | (x[13] << 16); w1.w = x[14] | (x[15] << 16);
    LAS u32x4* d = (LAS u32x4*)(lds + HL_IT + v * 144 + seg * 32); d[0] = w0; d[1] = w1;
}
__device__ __forceinline__ void hg_h1_run(const float* LF, const bf16* Zi, bf16* DS, float* DEC, bf16* AGG, float* DAGG, LAS unsigned char* lds, int bh, int j8, int tid, int wave, int lane) {
    const int u0 = bh * 32 + j8;
    HgRegs R; hg_load<false>(LF, Zi, Zi, u0, tid, R);
    const int r = lane & 15, q = lane >> 4;
    LAS float* decl = (LAS float*)(lds + HL_SSQ);
    f32x4 agg[8]; f32x4 dagg = {1.f, 1.f, 1.f, 1.f};
#pragma unroll
    for (int vt = 0; vt < 8; ++vt) agg[vt] = (f32x4){0.f, 0.f, 0.f, 0.f};
    for (int i = 0; i < 8; ++i) {
        const int unit = u0 + i;
        float bc[16], blast;
        hg_stage_it(R.iv, lds, tid);
        hg_scan(lds, tid, R.lf, bc, blast);
        { const int k = tid & 127, seg = tid >> 7; float v[16];
#pragma unroll
          for (int j = 0; j < 16; ++j) v[j] = (1.f - __expf(R.lf[j])) * __expf(blast - bc[j]);
          u32x4 w0, w1; w0.x = cvt_pk_bf16(v[0], v[1]); w0.y = cvt_pk_bf16(v[2], v[3]); w0.z = cvt_pk_bf16(v[4], v[5]); w0.w = cvt_pk_bf16(v[6], v[7]);
          w1.x = cvt_pk_bf16(v[8], v[9]); w1.y = cvt_pk_bf16(v[10], v[11]); w1.z = cvt_pk_bf16(v[12], v[13]); w1.w = cvt_pk_bf16(v[14], v[15]);
          LAS u32x4* d = (LAS u32x4*)(lds + HL_KT + k * 144 + seg * 32); d[0] = w0; d[1] = w1;
          if (seg == 0) { const float e = __expf(blast); DEC[(size_t)unit * 128 + k] = e; decl[k] = e; } }
        if (i + 1 < 8) hg_load<false>(LF, Zi, Zi, unit + 1, tid, R);
        BLK_SYNC();
        bf16x8 af[2];
#pragma unroll
        for (int ks = 0; ks < 2; ++ks) af[ks] = *(const LAS bf16x8*)(lds + HL_KT + (16 * wave + r) * 144 + (ks * 32 + 8 * q) * 2);
        const f32x4 dk = *(const LAS f32x4*)(decl + 16 * wave + 4 * q);
        dagg = dagg * dk;
        bf16* dst = DS + (size_t)unit * 16384;
#pragma unroll
        for (int vt = 0; vt < 8; ++vt) { f32x4 acc = {0.f, 0.f, 0.f, 0.f};
#pragma unroll
            for (int ks = 0; ks < 2; ++ks) { const bf16x8 bfr = *(const LAS bf16x8*)(lds + HL_IT + (16 * vt + r) * 144 + (ks * 32 + 8 * q) * 2); acc = mfma16(af[ks], bfr, acc); }
            agg[vt] = dk * agg[vt] + acc;
            u32x2 w; w.x = cvt_pk_bf16(acc[0], acc[1]); w.y = cvt_pk_bf16(acc[2], acc[3]);
            *(u32x2*)(dst + (size_t)(16 * vt + r) * 128 + 16 * wave + 4 * q) = w; }
        BLK_SYNC();
    }
    { bf16* dst = AGG + (size_t)(bh * 4 + (j8 >> 3)) * 16384;
#pragma unroll
      for (int vt = 0; vt < 8; ++vt) { u32x2 w; w.x = cvt_pk_bf16(agg[vt][0], agg[vt][1]); w.y = cvt_pk_bf16(agg[vt][2], agg[vt][3]); *(u32x2*)(dst + (size_t)(16 * vt + r) * 128 + 16 * wave + 4 * q) = w; }
      if (r == 0) *(f32x4*)(DAGG + (size_t)(bh * 4 + (j8 >> 3)) * 128 + 16 * wave + 4 * q) = dagg; }
}
__device__ __forceinline__ void hg_h3_run(const Args& a, const float* LF, const bf16* Zq, const bf16* Zi, const bf16* Zg, const bf16* DS, const float* DEC, const bf16* AGG, const float* DAGG, bf16* YB, LAS unsigned char* lds, int bh, int j8, int tid, int wave, int lane) {
    const int r = lane & 15, q = lane >> 4, h = bh & 3, b = bh >> 2;
    f32x4 S[4][2];
#pragma unroll
    for (int ks = 0; ks < 4; ++ks) { S[ks][0] = (f32x4){0.f, 0.f, 0.f, 0.f}; S[ks][1] = S[ks][0]; }
    HgRegs R; hg_load<true>(LF, Zq, Zi, bh * 32 + j8, tid, R);
    { const bf16* sp = AGG + (size_t)bh * 4 * 16384 + (size_t)(16 * wave + r) * 128 + 8 * q; const float* dp = DAGG + (size_t)bh * 4 * 128 + 8 * q;
      for (int c = 0; c < (j8 >> 3); ++c) {
#pragma unroll
        for (int ks = 0; ks < 4; ++ks) { f32x4 d0, d1; unpack8(*(const u32x4*)(sp + (size_t)c * 16384 + ks * 32), d0, d1); const f32x4 e0 = *(const f32x4*)(dp + c * 128 + ks * 32), e1 = *(const f32x4*)(dp + c * 128 + ks * 32 + 4);
            S[ks][0] = e0 * S[ks][0] + d0; S[ks][1] = e1 * S[ks][1] + d1; } } }
    const float* gn = a.in[14] + h * 128 + (tid & 7) * 16;
    const f32x4 gn0 = *(const f32x4*)gn, gn1 = *(const f32x4*)(gn + 4), gn2 = *(const f32x4*)(gn + 8), gn3 = *(const f32x4*)(gn + 12);
    for (int i = 0; i < 8; ++i) {
        const int unit = bh * 32 + j8 + i; const size_t row0 = (size_t)b * SEQ + (j8 + i) * 64;
        bf16x8 sf[4]; u32x4 dsv[4]; f32x4 de[4][2];
        { const bf16* sp = DS + (size_t)unit * 16384 + (size_t)(16 * wave + r) * 128 + 8 * q; const float* dp = DEC + (size_t)unit * 128 + 8 * q;
#pragma unroll
          for (int ks = 0; ks < 4; ++ks) { dsv[ks] = *(const u32x4*)(sp + ks * 32); de[ks][0] = *(const f32x4*)(dp + ks * 32); de[ks][1] = *(const f32x4*)(dp + ks * 32 + 4); sf[ks] = __builtin_bit_cast(bf16x8, pack8(S[ks][0], S[ks][1])); } }
        const size_t oidx = (row0 + (tid >> 3)) * 512 + h * 128 + (tid & 7) * 16;
        const u32x4 zg0 = *(const u32x4*)(Zg + oidx), zg1 = *(const u32x4*)(Zg + oidx + 8);
        float bc[16], blast;
        hg_stage_it(R.iv, lds, tid);
        hg_scan(lds, tid, R.lf, bc, blast);
        { const int k = tid & 127, seg = tid >> 7;
          LAS bf16* qt = (LAS bf16*)(lds + HL_QT) + (seg * 16) * 136 + k; LAS bf16* kk = (LAS bf16*)(lds + HL_KK) + (seg * 16) * 136 + k;
#pragma unroll
          for (int j = 0; j < 16; ++j) { const float eb = __expf(bc[j]); qt[j * 136] = f2bf(__uint_as_float(R.qv[j] << 16) * eb); kk[j * 136] = f2bf((1.f - __expf(R.lf[j])) * __builtin_amdgcn_rcpf(eb)); } }
        if (i + 1 < 8) hg_load<true>(LF, Zq, Zi, unit + 1, tid, R);
        BLK_SYNC();
        { const int tt = wave >> 1;
#pragma unroll
          for (int e = 0; e < 2; ++e) { const int st = (wave & 1) * 2 + e; f32x4 acc = {0.f, 0.f, 0.f, 0.f};
            if (st <= tt) {
#pragma unroll
                for (int ks = 0; ks < 4; ++ks) { const bf16x8 af = *(const LAS bf16x8*)(lds + HL_QT + (16 * tt + r) * 272 + (ks * 32 + 8 * q) * 2), bfr = *(const LAS bf16x8*)(lds + HL_KK + (16 * st + r) * 272 + (ks * 32 + 8 * q) * 2); acc = mfma16(af, bfr, acc); }
            }
            LAS bf16* pt = (LAS bf16*)(lds + HL_PT) + (16 * tt + 4 * q) * 72 + 16 * st + r;
#pragma unroll
            for (int g_ = 0; g_ < 4; ++g_) { const int t = 16 * tt + 4 * q + g_, s = 16 * st + r; pt[g_ * 72] = (st <= tt && s <= t) ? f2bf(acc[g_]) : (bf16)0; } } }
        BLK_SYNC();
        f32x4 o[4];
#pragma unroll
        for (int tt = 0; tt < 4; ++tt) { o[tt] = (f32x4){0.f, 0.f, 0.f, 0.f};
#pragma unroll
            for (int ks = 0; ks < 4; ++ks) { const bf16x8 af = *(const LAS bf16x8*)(lds + HL_QT + (16 * tt + r) * 272 + (ks * 32 + 8 * q) * 2); o[tt] = mfma16(af, sf[ks], o[tt]); }
#pragma unroll
            for (int ks = 0; ks < 2; ++ks) { const bf16x8 af = *(const LAS bf16x8*)(lds + HL_PT + (16 * tt + r) * 144 + (ks * 32 + 8 * q) * 2), bfr = *(const LAS bf16x8*)(lds + HL_IT + (16 * wave + r) * 144 + (ks * 32 + 8 * q) * 2); o[tt] = mfma16(af, bfr, o[tt]); } }
        { LAS float* ol = (LAS float*)(lds + HL_OL); LAS float* ssq = (LAS float*)(lds + HL_SSQ);
#pragma unroll
          for (int tt = 0; tt < 4; ++tt)
#pragma unroll
            for (int g_ = 0; g_ < 4; ++g_) { const int t = 16 * tt + 4 * q + g_; const float v = o[tt][g_]; ol[t * 128 + 16 * wave + r] = v;
                const float s = row16_sum(v * v);
                if (r == 0) ssq[wave * 64 + t] = s; } }
#pragma unroll
        for (int ks = 0; ks < 4; ++ks) { f32x4 d0, d1; unpack8(dsv[ks], d0, d1); S[ks][0] = de[ks][0] * S[ks][0] + d0; S[ks][1] = de[ks][1] * S[ks][1] + d1; }
        BLK_SYNC();
        { const int t = tid >> 3; const LAS float* ssq = (const LAS float*)(lds + HL_SSQ); const LAS float* ol = (const LAS float*)(lds + HL_OL) + t * 128 + (tid & 7) * 16;
          float s = 0.f;
#pragma unroll
          for (int w = 0; w < 8; ++w) s += ssq[w * 64 + t];
          const float rstd = rsqrtf(s * (1.f / 128.f) + EPS);
          f32x4 g0, g1, g2, g3; unpack8(zg0, g0, g1); unpack8(zg1, g2, g3);
          const f32x4 x0 = *(const LAS f32x4*)(ol), x1 = *(const LAS f32x4*)(ol + 4), x2 = *(const LAS f32x4*)(ol + 8), x3 = *(const LAS f32x4*)(ol + 12);
          *(u32x4*)(YB + oidx) = pack8(x0 * rstd * gn0 * g0, x1 * rstd * gn1 * g1); *(u32x4*)(YB + oidx + 8) = pack8(x2 * rstd * gn2 * g2, x3 * rstd * gn3 * g3); }
        BLK_SYNC();
    }
}
constexpr int N_PHASES = 12;
#ifndef PROBE_PHASE
#define PROBE_PHASE -1
#endif
__global__ void __launch_bounds__(NWAVES * 64, 2) mk_fwd(Args args) {
    extern __shared__ __attribute__((aligned(16))) unsigned char lds_raw[];
    LAS unsigned char* lds = (LAS unsigned char*)lds_raw;
    LAS unsigned char* es = lds + EPI_OFF;
    const int tid = threadIdx.x, lane = tid & 63, wave = __builtin_amdgcn_readfirstlane(tid >> 6);
    const int G = gridDim.x; const int bx = blockIdx.x; const int vcu = (G % 8 == 0) ? (bx % 8) * (G / 8) + bx / 8 : bx;
    const PtrsLazy P{args.ws, (unsigned char*)args.out};
    const int lo = args.ph_lo, hi = args.ph_hi;
    volatile LAS unsigned* MISC = (volatile LAS unsigned*)(lds + LDS_BYTES - 64);
    if (tid < 16) MISC[tid] = 0u;
    __syncthreads();
    XcdBarrier bar; bar.bar = (unsigned*)(args.ws + WS_CTL); bar.x = 0; bar.st = nullptr;
    if (hi - lo > 1) bar = xcd_barrier_post((unsigned*)(args.ws + WS_CTL), MISC + 8);
#define IN(k) (lo <= (k) && (k) < hi && (k) != 3)
#ifndef REPEAT_PHASE
#define REPEAT_PHASE -1
#endif
#define REP(k)
#define SEAM(k) do { if (IN(k) && (lo <= (k) + 1 && (k) + 1 < hi)) xcd_barrier(bar); } while (0)

    if (IN(0)) REP(0) { phase_prologue(args, P, lds, vcu, G, wave, lane); __syncthreads(); for (int it = vcu; it < 512; it += G) s5_tables_item(args, (bf16*)(args.ws + WS_BT), (bf16*)(args.ws + WS_PM), (f32x2*)(args.ws + WS_L64), lds, it >> 4, it & 15, tid); SEAM(0); }
    if (IN(1)) REP(1) {
        pg8::Gemm g = pg8::plain_gemm(P.XN_(), D_MODEL, P.Win_(), D_MODEL); pg8::StaticOrder S; S.init(M, NIN, G, bx);
        EpiP1f E{P.UA_(), P.Zq_(), P.Zi_(), P.Zg_(), P.Ga_(), P.Gb_(), P.LF_(), P.LB_()};
        pg8::gemm_phase(lds, es, g, S, E); SEAM(1);
    }
        float* Sx = (float*)((unsigned char*)args.out + DO_SX); bf16* DS = (bf16*)(args.ws + WS_XN); float* DEC = (float*)(args.ws + WS_DEC);
    bf16* AGG = (bf16*)((unsigned char*)args.out + DO_AGG); float* DAGG = (float*)((unsigned char*)args.out + DO_DAGG); const f32x2* L64 = (const f32x2*)(args.ws + WS_L64);
    if (IN(2)) REP(2) {
        { const int g_ = vcu >> 3, pm_ = (vcu >> 2) & 1, kq = vcu & 3;
          pg8::Gemm g; g.A = (const char*)P.UA_() + ((size_t)g_ * 512 + pm_ * 256) * UAK * 2 + kq * 512; g.B = (const char*)(args.ws + WS_PM) + (size_t)g_ * 128 * 2048 + kq * 512; g.lda = UAK * 2; g.ldb = 2048;
          g.a_pm = 0; g.a_pz = 0; g.b_pn = 0; g.b_pz = 0; g.hsA = 128L * UAK * 2; g.hsB = 0; g.nt = 4;
          OneUnit S{{pm_, kq, g_}}; EpiS5sum E{Sx};
          pg8::gemm_phase(lds, es, g, S, E); }
        hg_h1_run(P.LF_(), P.Zi_(), DS, DEC, AGG, DAGG, lds, vcu >> 2, (vcu & 3) * 8, tid, wave, lane);
        SEAM(2);
    }
    if (IN(4)) REP(4) {
        if (args.probe != 2) {
        { const int g_ = vcu >> 3, pm_ = (vcu >> 2) & 1; s5_scan(L64, Sx, P.UA_(), ((pm_ * 8 + (tid >> 6)) << 11) | (g_ << 6) | (tid & 63)); asm volatile("s_waitcnt vmcnt(0)" ::: "memory"); __syncthreads(); }
        { pg8::Gemm g; g.A = (const char*)P.UA_(); g.B = (const char*)(args.ws + WS_BT); g.lda = UAK * 2; g.ldb = UAK * 2; g.a_pm = 256L * UAK * 2; g.a_pz = 512L * UAK * 2; g.b_pn = 256L * UAK * 2; g.b_pz = 1024L * UAK * 2;
          g.hsA = 128L * UAK * 2; g.hsB = 128L * UAK * 2; g.nt = UAK / 64;
          S5Order S{vcu, G}; EpiS5main E{P.UA_(), args.in[10], P.YA_()};
          pg8::gemm_phase(lds, es, g, S, E); }
        }
        if (args.probe != 1)
        hg_h3_run(args, P.LF_(), P.Zq_(), P.Zi_(), P.Zg_(), DS, DEC, AGG, DAGG, P.YB_(), lds, vcu >> 2, (vcu & 3) * 8, tid, wave, lane);
        SEAM(4);
    }

    if (IN(5)) REP(5) {
        { pg8::Gemm g = pg8::plain_gemm(P.YA_(), 512, P.Wglu_(), 512); pg8::StaticOrder S; S.init(M, 512, G, bx); EpiGluf E{P.YA_(), args.in[12], P.YA2_()}; pg8::gemm_phase(lds, es, g, S, E); }
        { pg8::Gemm g = pg8::plain_gemm(P.YB_(), 512, P.Wpb_(), 512); pg8::StaticOrder S; S.init(M, 1024, G, bx); EpiTf E{P.Gb_(), P.T_()}; pg8::gemm_phase(lds, es, g, S, E); }
        SEAM(5);
    }
    if (IN(6)) REP(6) { pg8::Gemm g = pg8::plain_gemm(P.YA2_(), 512, P.Wpa_(), 512); pg8::StaticOrder S; S.init(M, 1024, G, bx); EpiMf E{P.Ga_(), P.T_(), P.Mm_()}; pg8::gemm_phase(lds, es, g, S, E); SEAM(6); }
    if (IN(7)) REP(7) { pg8::Gemm g = pg8::plain_gemm(P.Mm_(), 1024, P.Wout_(), 1024); pg8::StaticOrder S; S.init(M, 1024, G, bx); EpiOutf E{args.in[0], args.in[18], args.out, P.XG_(), P.SS1_()}; pg8::gemm_phase(lds, es, g, S, E); SEAM(7); }
    if (IN(8)) REP(8) { pg8::Gemm g = pg8::plain_gemm(P.XG_(), 1024, P.Wup_(), 1024); pg8::StaticOrder S; S.init(M, NUP, G, bx); EpiUpf E{P.SS1_(), args.in[20], args.in[21], P.AF_(), P.HF_(), P.HL_()}; pg8::gemm_phase(lds, es, g, S, E); SEAM(8); }
    if (IN(9)) REP(9) { phase_fixup(args, P, vcu, G, tid); SEAM(9); }
    if (IN(10)) REP(10) { pg8::Gemm g = pg8::plain_gemm(P.AF_(), DFF, P.Wdn_(), DFF); pg8::StaticOrder S; S.init(M, 1024, G, bx); EpiDownf E{args.out, P.SS2_()}; pg8::gemm_phase(lds, es, g, S, E); SEAM(10); }
    if (IN(11)) REP(11) { phase_final(args, P, vcu, G, wave, lane); }
#undef IN
#undef SEAM
}

static void launch_phases(const Args& base, int lo, int hi, int grid, hipStream_t stream, int probe = 0) {
    Args a = base; a.ph_lo = lo; a.ph_hi = hi; a.probe = probe;
    hipLaunchKernelGGL(mk_fwd, dim3(grid), dim3(NWAVES * 64), LDS_BYTES, stream, a);
}

extern "C" void kernel_launch(void* const* d_in, const int* in_sizes, int n_in, void* d_out, int out_size, void* d_ws, size_t ws_size, hipStream_t stream) {
    static int grid = 0;
    if (grid == 0) {
        if (n_in != 24 || in_sizes[0] != M * D_MODEL || out_size != M * D_MODEL || ws_size < WS_END) { fprintf(stderr, "kernel_launch: unexpected shapes (n_in %d in0 %d out %d ws %zu)\n", n_in, n_in > 0 ? in_sizes[0] : -1, out_size, ws_size); grid = -1; return; }
        int dev = 0, cus = 0, per_cu = 0;
        hipGetDevice(&dev); hipDeviceGetAttribute(&cus, hipDeviceAttributeMultiprocessorCount, dev);
        if (hipFuncSetAttribute((const void*)mk_fwd, hipFuncAttributeMaxDynamicSharedMemorySize, LDS_BYTES) != hipSuccess) { fprintf(stderr, "kernel_launch: hipFuncSetAttribute failed\n"); grid = -1; return; }
        if (hipOccupancyMaxActiveBlocksPerMultiprocessor(&per_cu, (const void*)mk_fwd, NWAVES * 64, LDS_BYTES) != hipSuccess || per_cu < 1) { fprintf(stderr, "kernel_launch: occupancy query says %d\n", per_cu); }
        (void)hipGetLastError();
        if (cus != 256) { fprintf(stderr, "kernel_launch: this kernel's phase programs are written for a 256-CU device (got %d CUs)\n", cus); grid = -1; return; }
        grid = cus;
    }
    if (grid < 0) return;
    Args a{};
    for (int i = 0; i < 24; ++i) a.in[i] = (const float*)d_in[i];
    a.out = (float*)d_out; a.ws = (unsigned char*)d_ws; a.probe = 0; a.pad = 0;
    hipMemsetAsync((char*)d_ws + WS_CTL, 0, XCD_BAR_WORDS * 4, stream);

    launch_phases(a, 0, N_PHASES, grid, stream);

}
```
